# Optimizing an MI355X kernel written in HIP

```python
import math
import jax
import jax.numpy as jnp
from jax import lax
import numpy as np

D_MODEL = 1024
BATCH = 8
SEQ = 4096
DEPTH = 4

CTX_LEN = 256
GRID_W = 64
NORM_EPS = 1e-6

HYENA_WIDTH = D_MODEL // 2
HYENA_ORDER = 2
HYENA_PROJ = (HYENA_ORDER + 1) * HYENA_WIDTH
SHORT_CONV = 3
FILTER_EMB = 33
FILTER_HIDDEN = 64
FILTER_FAST_DECAY = 0.3
FILTER_SLOW_DECAY = 1.5
FILTER_TARGET = 1e-2

DIFF_HEADS = 4
DIFF_HEAD_DIM = 64
DIFF_V_DIM = 2 * DIFF_HEAD_DIM
DIFF_QK_WIDTH = DIFF_HEADS * 2 * DIFF_HEAD_DIM
DIFF_WIDTH = DIFF_HEADS * DIFF_V_DIM
ROPE_BASE = 10000.0
ATTN_BLOCK = 128

IN_WIDTH = HYENA_PROJ + 2 * DIFF_QK_WIDTH + DIFF_WIDTH
MIX_WIDTH = HYENA_WIDTH + DIFF_WIDTH

POOL_WINDOWS = (2, 4, 8, 16)
POOL_GROUP = D_MODEL // len(POOL_WINDOWS)

N_EXPERTS = 16
EXPERT_FF = 2 * D_MODEL
EC_CAPACITY = 2

kernel_name = 'hybrid_hyena_diffattn_pool_ecmoe_dit'


def rms_norm(x, g):
    xf = x.astype(jnp.float32)
    y = xf * lax.rsqrt(jnp.mean(xf * xf, axis=-1, keepdims=True) + NORM_EPS)
    return (y * g.astype(jnp.float32)).astype(x.dtype)


def rope_1d(x, pos):
    nf = x.shape[-1] // 2
    inv = ROPE_BASE ** (-jnp.arange(nf, dtype=jnp.float32) / nf)
    ang = pos.astype(jnp.float32)[:, None] * inv[None, :]
    shape = (1, ang.shape[0]) + (1,) * (x.ndim - 3) + (nf,)
    cos = jnp.cos(ang).reshape(shape).astype(x.dtype)
    sin = jnp.sin(ang).reshape(shape).astype(x.dtype)
    x1, x2 = x[..., :nf], x[..., nf:]
    return jnp.concatenate([x1 * cos - x2 * sin, x1 * sin + x2 * cos], axis=-1)


def axial_rope(x, row, col):
    half = x.shape[-1] // 2
    return jnp.concatenate([rope_1d(x[..., :half], row), rope_1d(x[..., half:], col)], axis=-1)


def short_conv_centred(u, w, b):
    L = u.shape[1]
    r = SHORT_CONV // 2
    up = jnp.pad(u, ((0, 0), (r, r), (0, 0)))
    return sum(up[:, j:j + L] * w[j] for j in range(SHORT_CONV)) + b


def hyena_filters(L, w1, b1, w2, b2, w3, b3, freq, wout):
    f32 = jnp.float32
    t = jnp.linspace(0.0, 1.0, L, dtype=f32)[:, None]
    bands = (FILTER_EMB - 1) // 2
    w = 2.0 * math.pi * jnp.arange(L, dtype=f32)[:, None] / L
    f = jnp.linspace(1e-4, bands - 1, bands, dtype=f32)[None, :]
    z = jnp.concatenate([t, jnp.cos(f * w), -jnp.sin(f * w)], axis=-1)
    fr = freq.astype(f32)
    h = jnp.sin(fr * (z @ w1.astype(f32) + b1.astype(f32)))
    h = jnp.sin(fr * (h @ w2.astype(f32) + b2.astype(f32)))
    h = jnp.sin(fr * (h @ w3.astype(f32) + b3.astype(f32)))
    h = h @ wout.astype(f32)
    max_decay = math.log(FILTER_TARGET) / FILTER_FAST_DECAY
    min_decay = math.log(FILTER_TARGET) / FILTER_SLOW_DECAY
    deltas = jnp.abs(jnp.linspace(min_decay, max_decay, HYENA_WIDTH, dtype=f32))
    decay = jnp.exp(-t * deltas[None, :])
    return h.reshape(L, HYENA_ORDER, 2, HYENA_WIDTH) * decay[:, None, None, :]


def long_conv_bidir(u, h_fwd, h_bwd, bias):
    L = u.shape[1]
    n = 2 * L
    uf = u.astype(jnp.float32)
    hf = jnp.fft.rfft(h_fwd, n=n, axis=0)
    hb = jnp.fft.rfft(h_bwd, n=n, axis=0)
    y_f = jnp.fft.irfft(jnp.fft.rfft(uf, n=n, axis=1) * hf, n=n, axis=1)[:, :L]
    y_b = jnp.fft.irfft(jnp.fft.rfft(uf[:, ::-1], n=n, axis=1) * hb, n=n, axis=1)[:, :L][:, ::-1]
    return (y_f + y_b + uf * bias.astype(jnp.float32)).astype(u.dtype)


def hyena_operator(p, conv_w, conv_b, filt, bias):
    uc = short_conv_centred(p, conv_w, conv_b)
    *gates, z = jnp.split(uc, HYENA_ORDER + 1, axis=-1)
    for o, gate in enumerate(gates):
        z = gate * long_conv_bidir(z, filt[:, o, 0], filt[:, o, 1], bias[o])
    return z


def qk_heads(p):
    return p.reshape(p.shape[:2] + (DIFF_HEADS, 2, DIFF_HEAD_DIM))


def v_heads(p):
    return p.reshape(p.shape[:2] + (DIFF_HEADS, DIFF_V_DIM))


def diff_attend(q, k, v, lam):
    s = jnp.einsum('bqhmd,bkhmd->bhmqk', q, k).astype(jnp.float32) * (DIFF_HEAD_DIM ** -0.5)
    p = jax.nn.softmax(s, axis=-1)
    a = p[:, :, 0] - lam * p[:, :, 1]
    return jnp.einsum('bhqk,bkhe->bqhe', a.astype(v.dtype), v)


def latent_diff_attention(q, k_lat, v_lat, k_ctx, v_ctx, lam):
    B, S = q.shape[:2]
    k_all = jnp.concatenate([k_ctx, k_lat], axis=1)
    v_all = jnp.concatenate([v_ctx, v_lat], axis=1)
    nblk = S // ATTN_BLOCK
    qb = jnp.moveaxis(q.reshape((B, nblk, ATTN_BLOCK) + q.shape[2:]), 1, 0)
    o = lax.map(lambda qi: diff_attend(qi, k_all, v_all, lam), qb)
    return jnp.moveaxis(o, 0, 1).reshape((B, S) + o.shape[3:])


def diff_out(o, subln_g, lam_init):
    return (rms_norm(o, subln_g) * (1.0 - lam_init)).reshape(o.shape[:2] + (DIFF_WIDTH,))


def hybrid_mixer(a, ac, ctx_full, lam_init, row, col, w_in, w_out, conv_w, conv_b,
                 filt_params, hy_bias, q_g, k_g, lam_vec, subln_g):
    lv = lam_vec.astype(jnp.float32)
    lam = jnp.exp(jnp.sum(lv[0] * lv[1])) - jnp.exp(jnp.sum(lv[2] * lv[3])) + lam_init
    S = a.shape[1]
    q_off = HYENA_PROJ
    kv_off = HYENA_PROJ + DIFF_QK_WIDTH
    v_off = kv_off + DIFF_QK_WIDTH
    p = a @ w_in
    hy = hyena_operator(p[..., :HYENA_PROJ], conv_w, conv_b, hyena_filters(S, *filt_params), hy_bias)
    q = axial_rope(rms_norm(qk_heads(p[..., q_off:kv_off]), q_g), row, col)
    k = axial_rope(rms_norm(qk_heads(p[..., kv_off:v_off]), k_g), row, col)
    v = v_heads(p[..., v_off:])
    pc = ac @ (w_in if ctx_full else w_in[:, kv_off:])
    pc_kv = pc[..., kv_off:] if ctx_full else pc
    kc = rms_norm(qk_heads(pc_kv[..., :DIFF_QK_WIDTH]), k_g)
    vc = v_heads(pc_kv[..., DIFF_QK_WIDTH:])
    o = latent_diff_attention(q, k, v, kc, vc, lam)
    y = jnp.concatenate([hy, diff_out(o, subln_g, lam_init)], axis=-1) @ w_out
    if not ctx_full:
        return y, None
    Lc = ac.shape[1]
    hyc = hyena_operator(pc[..., :HYENA_PROJ], conv_w, conv_b, hyena_filters(Lc, *filt_params), hy_bias)
    qc = rms_norm(qk_heads(pc[..., q_off:kv_off]), q_g)
    oc = diff_attend(qc, kc, vc, lam)
    yc = jnp.concatenate([hyc, diff_out(oc, subln_g, lam_init)], axis=-1) @ w_out
    return y, yc


def multiscale_pool(h, pool_w, pool_scale):
    B, L, D = h.shape
    hf = h.astype(jnp.float32)
    cs = jnp.concatenate([jnp.zeros((B, 1, D), jnp.float32), jnp.cumsum(hf, axis=1)], axis=1)
    t = jnp.arange(L)
    groups = []
    for gi, w in enumerate(POOL_WINDOWS):
        lo = jnp.clip(t - w // 2, 0, L)
        hi = jnp.clip(t + w // 2, 0, L)
        sl = slice(gi * POOL_GROUP, (gi + 1) * POOL_GROUP)
        cg = cs[..., sl]
        cnt = (hi - lo).astype(jnp.float32)[None, :, None]
        mean = (jnp.take(cg, hi, axis=1) - jnp.take(cg, lo, axis=1)) / cnt
        groups.append(mean - hf[..., sl])
    p = jnp.stack(groups, axis=2).astype(h.dtype)
    y = jnp.einsum('blgc,gcd->blgd', p, pool_w).reshape(B, L, D)
    return y * pool_scale


def expert_choice_ffn(h, router_w, w_gate, w_up, w_down):
    B, n, D = h.shape
    cap = EC_CAPACITY * n // N_EXPERTS
    aff = jax.nn.softmax((h @ router_w).astype(jnp.float32), axis=-1)
    g, idx = lax.top_k(jnp.swapaxes(aff, 1, 2), cap)
    xs = jax.vmap(lambda hb, ib: hb[ib])(h, idx)
    a = jnp.einsum('becd,edf->becf', xs, w_gate)
    u = jnp.einsum('becd,edf->becf', xs, w_up)
    y = jnp.einsum('becf,efd->becd', jax.nn.silu(a) * u, w_down) * g[..., None].astype(h.dtype)
    return jax.vmap(lambda yb, ib: jnp.zeros((n, D), yb.dtype).at[ib.reshape(-1)].add(yb.reshape(-1, D)))(y, idx)


def setup_inputs(seed: int = 0) -> dict:
    key = jax.random.key(seed)
    ks = iter(jax.random.split(key, 32))

    def nrm(shape, scale):
        return jax.random.normal(next(ks), shape, jnp.float32) * scale

    D = D_MODEL
    n_even = (DEPTH + 1) // 2
    n_odd = DEPTH // 2
    return {
        'x': nrm((BATCH, SEQ, D), 1.0),
        'c': nrm((BATCH, D), 1.0),
        'ctx': nrm((BATCH, CTX_LEN, D), 1.0),
        'c_ctx': nrm((D,), 1.0),
        'ada_w': nrm((DEPTH, D, 6 * D), 0.5 * D ** -0.5),
        'ada_b': nrm((DEPTH, 6 * D), 0.02),
        'norm_mix_g': 1.0 + nrm((DEPTH, D), 0.02),
        'norm_ffn_g': 1.0 + nrm((DEPTH, D), 0.02),
        'w_in': nrm((n_even, D, IN_WIDTH), D ** -0.5),
        'w_out': nrm((n_even, MIX_WIDTH, D), MIX_WIDTH ** -0.5),
        'hy_conv_w': nrm((n_even, SHORT_CONV, HYENA_PROJ), SHORT_CONV ** -0.5),
        'hy_conv_b': nrm((n_even, HYENA_PROJ), 0.02),
        'hy_f_w1': nrm((n_even, FILTER_EMB, FILTER_HIDDEN), FILTER_EMB ** -0.5),
        'hy_f_b1': nrm((n_even, FILTER_HIDDEN), 0.02),
        'hy_f_w2': nrm((n_even, FILTER_HIDDEN, FILTER_HIDDEN), FILTER_HIDDEN ** -0.5),
        'hy_f_b2': nrm((n_even, FILTER_HIDDEN), 0.02),
        'hy_f_w3': nrm((n_even, FILTER_HIDDEN, FILTER_HIDDEN), FILTER_HIDDEN ** -0.5),
        'hy_f_b3': nrm((n_even, FILTER_HIDDEN), 0.02),
        'hy_f_freq': 1.0 + nrm((n_even, FILTER_HIDDEN), 0.02),
        'hy_f_wout': nrm((n_even, FILTER_HIDDEN, HYENA_ORDER * 2 * HYENA_WIDTH), 0.05 * FILTER_HIDDEN ** -0.5),
        'hy_bias': nrm((n_even, HYENA_ORDER, HYENA_WIDTH), 0.5),
        'q_norm_g': 1.0 + nrm((n_even, DIFF_HEAD_DIM), 0.02),
        'k_norm_g': 1.0 + nrm((n_even, DIFF_HEAD_DIM), 0.02),
        'diff_lambda': nrm((n_even, 4, DIFF_HEAD_DIM), 0.1),
        'subln_g': 1.0 + nrm((n_even, DIFF_V_DIM), 0.02),
        'pool_w': nrm((n_odd, len(POOL_WINDOWS), POOL_GROUP, POOL_GROUP), POOL_GROUP ** -0.5),
        'pool_scale': 1.0 + nrm((n_odd, D), 0.1),
        'router_w': nrm((DEPTH, D, N_EXPERTS), D ** -0.5),
        'exp_w_gate': nrm((DEPTH, N_EXPERTS, D, EXPERT_FF), D ** -0.5),
        'exp_w_up': nrm((DEPTH, N_EXPERTS, D, EXPERT_FF), D ** -0.5),
        'exp_w_down': nrm((DEPTH, N_EXPERTS, EXPERT_FF, D), EXPERT_FF ** -0.5),
    }


def reference(x, c, ctx, c_ctx, ada_w, ada_b, norm_mix_g, norm_ffn_g, w_in, w_out,
              hy_conv_w, hy_conv_b, hy_f_w1, hy_f_b1, hy_f_w2, hy_f_b2, hy_f_w3, hy_f_b3,
              hy_f_freq, hy_f_wout, hy_bias, q_norm_g, k_norm_g, diff_lambda, subln_g,
              pool_w, pool_scale, router_w, exp_w_gate, exp_w_up, exp_w_down):
    B, S, D = x.shape
    rows = S // GRID_W
    row = jnp.repeat(jnp.arange(rows, dtype=jnp.int32), GRID_W)
    col = jnp.tile(jnp.arange(GRID_W, dtype=jnp.int32), rows)
    last_attn = ((DEPTH - 1) // 2) * 2
    s_lat = jax.nn.silu(c)
    s_ctx = jax.nn.silu(c_ctx)
    h, hc = x, ctx
    for l in range(DEPTH):
        m = jnp.split((s_lat @ ada_w[l] + ada_b[l])[:, None, :], 6, axis=-1)
        mc = jnp.split(s_ctx @ ada_w[l] + ada_b[l], 6, axis=-1)
        ctx_full = l < last_attn
        a = rms_norm(h, norm_mix_g[l]) * (1 + m[1]) + m[0]
        ac = rms_norm(hc, norm_mix_g[l]) * (1 + mc[1]) + mc[0] if l <= last_attn else None
        if l % 2 == 0:
            e = l // 2
            lam_init = 0.8 - 0.6 * math.exp(-0.3 * l)
            filt_params = (hy_f_w1[e], hy_f_b1[e], hy_f_w2[e], hy_f_b2[e], hy_f_w3[e], hy_f_b3[e],
                           hy_f_freq[e], hy_f_wout[e])
            y, yc = hybrid_mixer(a, ac, ctx_full, lam_init, row, col, w_in[e], w_out[e],
                                 hy_conv_w[e], hy_conv_b[e], filt_params, hy_bias[e],
                                 q_norm_g[e], k_norm_g[e], diff_lambda[e], subln_g[e])
        else:
            o = l // 2
            y = multiscale_pool(a, pool_w[o], pool_scale[o])
            yc = multiscale_pool(ac, pool_w[o], pool_scale[o]) if ctx_full else None
        h = h + m[2] * y
        f_in = rms_norm(h, norm_ffn_g[l]) * (1 + m[4]) + m[3]
        h = h + m[5] * expert_choice_ffn(f_in, router_w[l], exp_w_gate[l], exp_w_up[l], exp_w_down[l])
        if ctx_full:
            hc = hc + mc[2] * yc
            fc_in = rms_norm(hc, norm_ffn_g[l]) * (1 + mc[4]) + mc[3]
            hc = hc + mc[5] * expert_choice_ffn(fc_in, router_w[l], exp_w_gate[l], exp_w_up[l], exp_w_down[l])
    return h
```

```cpp
#include <hip/hip_runtime.h>
#include <cstdio>
#include <cstdint>

#ifndef MK_ONE_LAUNCH
#define MK_ONE_LAUNCH 1
#endif

#define GAS __attribute__((address_space(1)))
#define LAS __attribute__((address_space(3)))
typedef unsigned short bf16_t;
typedef short bf16x8 __attribute__((ext_vector_type(8)));
typedef short s16x4 __attribute__((ext_vector_type(4)));
typedef float f32x4 __attribute__((ext_vector_type(4)));
typedef float f32x2 __attribute__((ext_vector_type(2)));
typedef float f32x8 __attribute__((ext_vector_type(8)));
typedef float f32x16 __attribute__((ext_vector_type(16)));
typedef unsigned u32x4 __attribute__((ext_vector_type(4)));
typedef unsigned u32x2 __attribute__((ext_vector_type(2)));

constexpr int NB = 8, SEQ = 4096, CTX = 256, RPB = SEQ + CTX, MT = NB * RPB, DM = 1024, DEPTH = 4;
constexpr int TPB = RPB / 256;
constexpr int HYW = 512, INW = 3072, NE = 16, FF = 2048, CAPL = 512, CAPC = 32, ME = NB * CAPL + NB * CAPC;
constexpr int NWAVES = 8, NTHR = 512;
constexpr float NORM_EPS = 1e-6f;

constexpr size_t al256(size_t x) { return (x + 255) / 256 * 256; }
constexpr size_t WS_CTL = 0, CTL_BYTES = 1u << 20;
constexpr size_t WS_MODS = WS_CTL + CTL_BYTES;
constexpr size_t WS_WINT = al256(WS_MODS + (size_t)4 * 9 * 6144 * 4);
constexpr size_t WS_WOUTT = al256(WS_WINT + (size_t)2 * 3072 * 1024 * 2);
constexpr size_t WS_POOLT = al256(WS_WOUTT + (size_t)2 * 1024 * 1024 * 2);
constexpr size_t WS_FILTF = al256(WS_POOLT + (size_t)2 * 1024 * 256 * 2);
constexpr size_t WS_FILTC = al256(WS_FILTF + (size_t)2 * 2 * 2 * 512 * 4096 * 4);
constexpr size_t WS_GR = al256(WS_FILTC + (size_t)2 * 2 * 512 * 256 * 4);
constexpr size_t WS_GRC = al256(WS_GR + (size_t)2 * 512 * 2 * 8192 * 2);
constexpr size_t WS_H = al256(WS_GRC + (size_t)512 * 2 * 512 * 4);
constexpr size_t WS_ABUF = al256(WS_H + (size_t)MT * DM * 4);
constexpr size_t WS_P = al256(WS_ABUF + (size_t)MT * DM * 2);
constexpr size_t P_PART = (size_t)MT * 512 * 2;
constexpr size_t WS_HYT = al256(WS_P + 6 * P_PART);
constexpr size_t HYT_PART = (size_t)NB * 512 * SEQ * 2;
constexpr size_t WS_HYC = al256(WS_HYT + 4 * HYT_PART);
constexpr size_t WS_QB = al256(WS_HYC + (size_t)3 * NB * 512 * CTX * 2);
constexpr size_t WS_KB = al256(WS_QB + P_PART);
constexpr size_t WS_OBUF = al256(WS_KB + P_PART);
constexpr size_t WS_AFF = al256(WS_OBUF + (size_t)2 * MT * 512 * 4);
constexpr size_t WS_RSTD = al256(WS_AFF + (size_t)NB * NE * RPB * 4);
constexpr size_t WS_TOKROW = al256(WS_RSTD + (size_t)MT * 4);
constexpr size_t WS_PGATE = al256(WS_TOKROW + (size_t)NE * ME * 4);
constexpr size_t WS_SLOT = al256(WS_PGATE + (size_t)NE * ME * 4);
constexpr size_t WS_XS = al256(WS_SLOT + (size_t)NB * NE * RPB * 4);
constexpr size_t WS_ACT = al256(WS_XS + (size_t)NE * ME * DM * 2);
constexpr size_t WS_YP = al256(WS_ACT + (size_t)NE * ME * FF * 2);
constexpr size_t WS_W13T = al256(WS_YP + (size_t)NE * ME * DM * 2);
constexpr size_t W13T_BYTES = (size_t)NE * 4096 * 1024 * 2, W2T_BYTES = (size_t)NE * 1024 * 2048 * 2;
constexpr size_t WS_W2T = al256(WS_W13T + 2 * W13T_BYTES);
constexpr size_t WS_END = al256(WS_W2T + 2 * W2T_BYTES);

constexpr int LDS_BYTES = 147456;
constexpr int MISC_OFF = LDS_BYTES - 256;

#define LDS_WAIT() asm volatile("s_waitcnt lgkmcnt(0)" ::: "memory")
#define VM_WAIT() asm volatile("s_waitcnt vmcnt(0)" ::: "memory")
typedef __bf16 bf16x2_t __attribute__((ext_vector_type(2)));
__device__ __forceinline__ unsigned cvt_pk_bf16(float lo, float hi) { f32x2 v = {lo, hi}; bf16x2_t b = __builtin_convertvector(v, bf16x2_t); return __builtin_bit_cast(unsigned, b); }
#ifndef NT_STORES
#define NT_STORES 0
#endif
__device__ __forceinline__ void st16(void* p, u32x4 v) {
#if NT_STORES
    __builtin_nontemporal_store(v, (u32x4*)p);
#else
    *(u32x4*)p = v;
#endif
}
__device__ __forceinline__ void st8(void* p, u32x2 v) {
#if NT_STORES
    __builtin_nontemporal_store(v, (u32x2*)p);
#else
    *(u32x2*)p = v;
#endif
}
__device__ __forceinline__ void st16f(void* p, f32x4 v) { st16(p, __builtin_bit_cast(u32x4, v)); }
__device__ __forceinline__ unsigned short f2bf(float f) { return (unsigned short)(cvt_pk_bf16(f, 0.f) & 0xffffu); }
__device__ __forceinline__ float bf2f(unsigned short h) { return __builtin_bit_cast(float, (unsigned)h << 16); }
__device__ __forceinline__ float bflo(unsigned w) { return __builtin_bit_cast(float, w << 16); }
typedef _Float16 h16_t; typedef _Float16 h16x4 __attribute__((ext_vector_type(4)));
__device__ __forceinline__ f32x4 h4_f32(u32x2 w) { return __builtin_convertvector(__builtin_bit_cast(h16x4, w), f32x4); }
__device__ __forceinline__ u32x2 f32_h4(f32x4 v) { return __builtin_bit_cast(u32x2, __builtin_convertvector(v, h16x4)); }
__device__ __forceinline__ float bfhi(unsigned w) { return __builtin_bit_cast(float, w & 0xffff0000u); }
__device__ __forceinline__ float wave_sum(float v) {
#pragma unroll
    for (int o = 1; o < 64; o <<= 1) v += __shfl_xor(v, o);
    return v;
}
__device__ __forceinline__ float sin_rad(float x) { float r = x * 0.15915494309189535f; r = r - rintf(r); return __builtin_amdgcn_sinf(r); }
__device__ __forceinline__ float sin_rev(float r) { r = r - rintf(r); return __builtin_amdgcn_sinf(r); }
__device__ __forceinline__ float cos_rev(float r) { r = r - rintf(r); return __builtin_amdgcn_cosf(r); }
__device__ __forceinline__ float siluf(float x) { return x / (1.f + __expf(-x)); }

#define XB_TMO      128
#define XB_XCNT(j)  (256  + 64 * (j))
#define XB_XSUB(j)  (1280 + 64 * (j))
#define XB_XGEN(j)  (2304 + 64 * (j))
#define XB_TOP      3328
#define XB_TOPGEN   3392
#define XCD_BAR_WORDS 3456
#define XB_SPIN_CAP (1u << 20)

__device__ __forceinline__ unsigned xb_ld(unsigned* p)              { return __hip_atomic_load(p, __ATOMIC_RELAXED, __HIP_MEMORY_SCOPE_AGENT); }
__device__ __forceinline__ unsigned xb_add(unsigned* p, unsigned v) { return __hip_atomic_fetch_add(p, v, __ATOMIC_RELAXED, __HIP_MEMORY_SCOPE_AGENT); }
__device__ __forceinline__ unsigned xb_xcc_id() { return (unsigned)__builtin_amdgcn_s_getreg((3 << 11) | 20) & 0xFu; }
#define XB_SPIN(cond, bar) do { unsigned _sp = 0; while (cond) { __builtin_amdgcn_s_sleep(1); \
    if ((++_sp & 255u) == 0u) { if (xb_ld(&(bar)[XB_TMO])) break; if (_sp > XB_SPIN_CAP) { atomicAdd(&(bar)[XB_TMO], 1u); break; } } } } while (0)

struct XcdBarrier {
    unsigned* bar; unsigned x;
    volatile LAS unsigned* st;
};

__device__ __forceinline__ XcdBarrier xcd_barrier_post(unsigned* bar, volatile LAS unsigned* st) {
    XcdBarrier b; b.bar = bar; b.x = xb_xcc_id(); b.st = st;
    if (threadIdx.x == 0) (void)xb_add(&bar[XB_XCNT(b.x)], 1u);
    return b;
}
__device__ __forceinline__ void xcd_barrier_complete(unsigned* bar, unsigned x, unsigned& nloc, unsigned& nx) {
    const unsigned G = gridDim.x * gridDim.y * gridDim.z;
    unsigned sum, cnt, mine, sp = 0u;
    for (;;) {
        sum = 0u; cnt = 0u; mine = 0u;
#pragma unroll
        for (unsigned j = 0; j < 16; ++j) { const unsigned c = xb_ld(&bar[XB_XCNT(j)]); sum += c; cnt += (c > 0u) ? 1u : 0u; mine = (j == x) ? c : mine; }
        if (sum == G) break;
        __builtin_amdgcn_s_sleep(1);
        if ((++sp & 255u) == 0u) { if (xb_ld(&bar[XB_TMO])) break; if (sp > XB_SPIN_CAP) { atomicAdd(&bar[XB_TMO], 1u); break; } }
    }
    nloc = mine > 0u ? mine : 1u; nx = cnt > 0u ? cnt : 1u;
}

__device__ __forceinline__ void xcd_barrier(const XcdBarrier& b) {
    asm volatile("s_waitcnt vmcnt(0)" ::: "memory");
    __syncthreads();
    if (threadIdx.x == 0) {
        unsigned* bar = b.bar;
        __builtin_amdgcn_s_waitcnt(0);
        unsigned nloc = b.st[0], nx = b.st[1];
        if (nloc == 0u) { xcd_barrier_complete(bar, b.x, nloc, nx); b.st[0] = nloc; b.st[1] = nx; }
        const unsigned old = xb_add(&bar[XB_XSUB(b.x)], 1u);
        const unsigned gen = old / nloc;
        if (old + 1u == (gen + 1u) * nloc) {
            __builtin_amdgcn_fence(__ATOMIC_RELEASE, "agent");
            asm volatile("s_waitcnt vmcnt(0)" ::: "memory");
            const unsigned og = xb_add(&bar[XB_TOP], 1u);
            const unsigned tg = og / nx;
            if (og + 1u == (tg + 1u) * nx) xb_add(&bar[XB_TOPGEN], 1u);
            else XB_SPIN(xb_ld(&bar[XB_TOPGEN]) == tg, bar);
            __builtin_amdgcn_fence(__ATOMIC_ACQUIRE, "agent");
            xb_add(&bar[XB_XGEN(b.x)], 1u);
            asm volatile("s_waitcnt vmcnt(0)" ::: "memory");
        } else {
            XB_SPIN(xb_ld(&bar[XB_XGEN(b.x)]) == gen, bar);
            __builtin_amdgcn_fence(__ATOMIC_ACQUIRE, "agent");
            asm volatile("s_waitcnt vmcnt(0)" ::: "memory");
        }
    }
    __syncthreads();
}


namespace pg8 {
#define PG8_LAS __attribute__((address_space(3)))
constexpr int BM = 256, BK = 64, HALF = 128, HTB = HALF * BK * 2, STAGE_BYTES = 8 * HTB, NXCD = 8, WGM = 8;
__host__ __device__ __forceinline__ int lds_byte(int r, int c) { const int st = (r >> 4) * 2 + (c >> 5), rr = r & 15, cc = c & 31, ob = rr * 64 + cc * 2; return st * 1024 + (ob ^ (((ob >> 9) & 1) << 5)); }
__host__ __device__ __forceinline__ void stage_rc(int b, int& R, int& C) { const int st = b / 1024, sb = b % 1024, swz = sb ^ (((sb >> 9) & 1) << 5); R = (st >> 1) * 16 + swz / 64; C = (st & 1) * 32 + (swz % 64) / 2; }
__host__ __device__ __forceinline__ int perm32(int rho) { const int n = rho >> 4, i = rho & 15; return 8 * (i >> 2) + 4 * n + (i & 3); }
struct Unit { int pm, pn, e, x; };
struct Gemm { const bf16_t* A; const bf16_t* Bt; int K, lda, ldb; };
template <class Epi, class Sched, bool ALIGN_EPI = false, bool SP2 = false, bool GATHER = false>
__device__ __forceinline__ void gemm_phase(PG8_LAS unsigned char* lds, const Gemm g, const Sched& S, const Epi& E, const PG8_LAS unsigned short* gtab = nullptr) {
    int tid = threadIdx.x; asm volatile("" : "+v"(tid)); const int wid = __builtin_amdgcn_readfirstlane(tid >> 6), lane = tid & 63, wr = wid >> 2, wc = wid & 3, fr = lane & 15, fq = lane >> 4;
    const int K = g.K, nt = K / BK;
    unsigned voffA[2], voffB[2], Cb[2]; int Rr[2];
#pragma unroll
    for (int i = 0; i < 2; ++i) { int R, C; stage_rc(tid * 16 + i * 8192, R, C); const int Rb = Epi::PERM ? ((R & ~31) + perm32(R & 31)) : R;
        voffA[i] = (unsigned)(R * g.lda + C) * 2u; voffB[i] = (unsigned)(Rb * g.ldb + C) * 2u; Rr[i] = R; Cb[i] = (unsigned)C * 2u; }
    const size_t kstep = (size_t)(BK * 2);
    const size_t hstepA = (size_t)HALF * g.lda * 2, hstepB = (size_t)HALF * g.ldb * 2;
    const unsigned ldsw = (unsigned)wid * 1024u;
    const int aoff = lds_byte(wr * 64 + fr, fq * 8), boff = lds_byte(wc * 32 + fr, fq * 8);
#define PG8_SA(b, h) (((b) * 2 + (h)) * HTB)
#define PG8_SB(b, h) ((4 + (b) * 2 + (h)) * HTB)
#define PG8_STAGE(bufoff, gbase, voff) do { _Pragma("unroll") for (int _i = 0; _i < 2; ++_i) \
        __builtin_amdgcn_global_load_lds((const unsigned*)((const char*)(gbase) + (voff)[_i]), (PG8_LAS unsigned*)(lds + (bufoff) + ldsw + _i * 8192), 16, 0, 0); } while (0)
#define PG8_LDA(dst, b, h) do { _Pragma("unroll") for (int m = 0; m < 4; ++m) _Pragma("unroll") for (int k = 0; k < 2; ++k) dst[m][k] = *(const PG8_LAS bf16x8*)(lds + PG8_SA(b, h) + aoff + m * 2048 + k * 1024); } while (0)
#define PG8_LDB(dst, b, h) do { _Pragma("unroll") for (int n = 0; n < 2; ++n) _Pragma("unroll") for (int k = 0; k < 2; ++k) dst[n][k] = *(const PG8_LAS bf16x8*)(lds + PG8_SB(b, h) + boff + n * 2048 + k * 1024); } while (0)
#define PG8_MMA(ai, bj, At, Bt) do { __builtin_amdgcn_s_setprio(1); _Pragma("unroll") for (int m = 0; m < 4; ++m) _Pragma("unroll") for (int n = 0; n < 2; ++n) _Pragma("unroll") for (int k = 0; k < 2; ++k) \
        acc[ai][bj][m][n] = __builtin_amdgcn_mfma_f32_16x16x32_bf16(Bt[n][k], At[m][k], acc[ai][bj][m][n], 0, 0, 0); __builtin_amdgcn_s_setprio(0); } while (0)
#define PG8_WAIT_V(n) asm volatile("s_waitcnt vmcnt(" #n ")" ::: "memory")
#define PG8_WAIT_L(n) asm volatile("s_waitcnt lgkmcnt(" #n ")" ::: "memory")
#define PG8_BAR __builtin_amdgcn_s_barrier()
#define PG8_SCHED __builtin_amdgcn_sched_barrier(0)
    Unit cur, nxt; int ui = 0;
    if (!S.next(0, cur)) return;
    f32x4 acc[2][2][4][2];
#pragma unroll
    for (int a = 0; a < 2; ++a)
#pragma unroll
        for (int b = 0; b < 2; ++b)
#pragma unroll
            for (int m = 0; m < 4; ++m)
#pragma unroll
                for (int n = 0; n < 2; ++n) acc[a][b][m][n] = (f32x4){0.f, 0.f, 0.f, 0.f};
    bf16x8 At[4][2], B0[2][2], B1[2][2];
    u32x4 pend[8]; bf16_t* pbase = nullptr; bool have_pend = false;
    const char* cA = GATHER ? (const char*)g.A : (const char*)g.A + S.aoff(cur); const char* cB = (const char*)g.Bt + S.boff(cur);
    unsigned oc0[2], oc1[2], on0[2], on1[2];
#pragma unroll
    for (int i = 0; i < 2; ++i) {
        if constexpr (GATHER) { oc0[i] = (unsigned)gtab[Rr[i]] * (unsigned)(g.lda * 2) + Cb[i]; oc1[i] = (unsigned)gtab[HALF + Rr[i]] * (unsigned)(g.lda * 2) + Cb[i]; }
        else { oc0[i] = voffA[i]; oc1[i] = voffA[i] + (unsigned)hstepA; }
        on0[i] = oc0[i]; on1[i] = oc1[i]; }
    S.a_ready(cur);
    if constexpr (SP2) {
        PG8_STAGE(PG8_SB(0, 0), cB, voffB); PG8_STAGE(PG8_SB(0, 1), cB + hstepB, voffB); PG8_STAGE(PG8_SA(0, 0), cA, oc0); PG8_STAGE(PG8_SA(0, 1), cA, oc1);
        if (wr == 1) PG8_BAR;
        PG8_WAIT_V(2); PG8_BAR;
        PG8_STAGE(PG8_SB(1, 0), cB + kstep, voffB); PG8_STAGE(PG8_SA(1, 0), cA + kstep, oc0); PG8_STAGE(PG8_SB(1, 1), cB + hstepB + kstep, voffB);
        PG8_WAIT_V(6); PG8_BAR;
    } else {
        PG8_STAGE(PG8_SB(0, 0), cB, voffB); PG8_STAGE(PG8_SA(0, 0), cA, oc0); PG8_STAGE(PG8_SB(0, 1), cB + hstepB, voffB); PG8_STAGE(PG8_SA(0, 1), cA, oc1);
        if (wr == 1) PG8_BAR;
        PG8_WAIT_V(4); PG8_BAR;
        PG8_STAGE(PG8_SB(1, 0), cB + kstep, voffB); PG8_STAGE(PG8_SA(1, 0), cA + kstep, oc0); PG8_STAGE(PG8_SB(1, 1), cB + hstepB + kstep, voffB);
        PG8_WAIT_V(6); PG8_BAR;
    }
    for (;;) {
        const bool has_next = S.next(ui + 1, nxt);
        const char* nA = GATHER ? cA : (has_next ? (const char*)g.A + S.aoff(nxt) : cA); const char* nB = has_next ? (const char*)g.Bt + S.boff(nxt) : cB;
        if constexpr (GATHER) {
#pragma unroll
            for (int i = 0; i < 2; ++i) { if (has_next) { on0[i] = (unsigned)gtab[(ui + 1) * 256 + Rr[i]] * (unsigned)(g.lda * 2) + Cb[i]; on1[i] = (unsigned)gtab[(ui + 1) * 256 + HALF + Rr[i]] * (unsigned)(g.lda * 2) + Cb[i]; } else { on0[i] = oc0[i]; on1[i] = oc1[i]; } } }
        for (int t = 0; t < nt; t += 2) {
            const bool last = (t == nt - 2);
            const char* a1 = cA + (size_t)(t + 1) * kstep;
            const char* a2 = last ? nA : cA + (size_t)(t + 2) * kstep; const char* b2 = last ? nB : cB + (size_t)(t + 2) * kstep;
            unsigned os0[2], os1[2];
#pragma unroll
            for (int i = 0; i < 2; ++i) { os0[i] = (GATHER && last) ? on0[i] : oc0[i]; os1[i] = (GATHER && last) ? on1[i] : oc1[i]; }
            const char* a3 = a2 + kstep; const char* b3 = b2 + kstep;
            if (last && has_next) S.a_ready(nxt);
            if constexpr (SP2) {
            PG8_LDB(B0, 0, 0); PG8_LDB(B1, 0, 1); PG8_SCHED; PG8_LDA(At, 0, 0); PG8_STAGE(PG8_SA(1, 1), a1, oc1);
            PG8_WAIT_V(8); PG8_WAIT_L(0); PG8_BAR; PG8_MMA(0, 0, At, B0); PG8_MMA(0, 1, At, B1); PG8_BAR; PG8_SCHED;
            if constexpr (Epi::DEFER) { if (have_pend) {
                if (t == 0) { E.store_piece(pbase, 0, pend[0]); E.store_piece(pbase, 1, pend[1]); } else if (t == 2) { E.store_piece(pbase, 2, pend[2]); E.store_piece(pbase, 3, pend[3]); }
                else if (t == 4) { E.store_piece(pbase, 4, pend[4]); E.store_piece(pbase, 5, pend[5]); } else if (t == 6) { E.store_piece(pbase, 6, pend[6]); E.store_piece(pbase, 7, pend[7]); have_pend = false; } } }
            PG8_LDA(At, 0, 1); PG8_STAGE(PG8_SB(0, 0), b2, voffB); PG8_STAGE(PG8_SB(0, 1), b2 + hstepB, voffB); PG8_STAGE(PG8_SA(0, 0), a2, os0);
            PG8_WAIT_V(8); PG8_WAIT_L(0); PG8_BAR; PG8_MMA(1, 0, At, B0); PG8_MMA(1, 1, At, B1); PG8_BAR; PG8_SCHED;
            PG8_LDB(B0, 1, 0); PG8_LDB(B1, 1, 1); PG8_SCHED; PG8_LDA(At, 1, 0); PG8_STAGE(PG8_SA(0, 1), a2, os1);
            PG8_WAIT_V(8); PG8_WAIT_L(0); PG8_BAR; PG8_MMA(0, 0, At, B0); PG8_MMA(0, 1, At, B1); PG8_BAR; PG8_SCHED;
            PG8_LDA(At, 1, 1); PG8_STAGE(PG8_SB(1, 0), b3, voffB); PG8_STAGE(PG8_SB(1, 1), b3 + hstepB, voffB); PG8_STAGE(PG8_SA(1, 0), a3, os0);
            PG8_WAIT_V(8); PG8_WAIT_L(0); PG8_BAR; PG8_MMA(1, 0, At, B0); PG8_MMA(1, 1, At, B1); PG8_BAR; PG8_SCHED;
            } else {
            PG8_LDB(B0, 0, 0); PG8_SCHED; PG8_LDA(At, 0, 0); PG8_STAGE(PG8_SA(1, 1), a1, oc1);
            PG8_WAIT_L(8); PG8_BAR; PG8_WAIT_L(0); PG8_MMA(0, 0, At, B0); PG8_BAR; PG8_SCHED;
            PG8_LDB(B1, 0, 1); PG8_STAGE(PG8_SB(0, 0), b2, voffB);
            PG8_BAR; PG8_WAIT_L(0); PG8_MMA(0, 1, At, B1); PG8_BAR;
            PG8_LDA(At, 0, 1); PG8_STAGE(PG8_SA(0, 0), a2, os0);
            PG8_BAR; PG8_WAIT_L(0); PG8_MMA(1, 0, At, B0); PG8_BAR; PG8_SCHED;
            PG8_STAGE(PG8_SB(0, 1), b2 + hstepB, voffB);
            PG8_WAIT_V(6); PG8_BAR; PG8_MMA(1, 1, At, B1); PG8_BAR;
            PG8_LDB(B0, 1, 0); PG8_SCHED; PG8_LDA(At, 1, 0); PG8_STAGE(PG8_SA(0, 1), a2, os1);
            PG8_WAIT_L(8); PG8_BAR; PG8_WAIT_L(0); PG8_MMA(0, 0, At, B0); PG8_BAR; PG8_SCHED;
            PG8_LDB(B1, 1, 1); PG8_STAGE(PG8_SB(1, 0), b3, voffB);
            PG8_BAR; PG8_WAIT_L(0); PG8_MMA(0, 1, At, B1); PG8_BAR;
            PG8_LDA(At, 1, 1); PG8_STAGE(PG8_SA(1, 0), a3, os0);
            PG8_BAR; PG8_WAIT_L(0); PG8_MMA(1, 0, At, B0); PG8_BAR; PG8_SCHED;
            PG8_STAGE(PG8_SB(1, 1), b3 + hstepB, voffB);
            PG8_WAIT_V(6); PG8_BAR; PG8_MMA(1, 1, At, B1); PG8_BAR;
            }
        }
        if constexpr (ALIGN_EPI) { if (wr == 0) PG8_BAR; }
        if constexpr (Epi::DEFER) { pbase = E.pack(acc, cur, wr, wc, fr, fq, pend); have_pend = true; }
        else if constexpr (!Epi::AFTER_DRAIN) { E(acc, cur, wr, wc, fr, fq); S.done(cur); }
        if (!has_next) break;
#pragma unroll
        for (int a = 0; a < 2; ++a)
#pragma unroll
            for (int b = 0; b < 2; ++b)
#pragma unroll
                for (int m = 0; m < 4; ++m)
#pragma unroll
                    for (int n = 0; n < 2; ++n) acc[a][b][m][n] = (f32x4){0.f, 0.f, 0.f, 0.f};
        cur = nxt; cA = nA; cB = nB; ++ui;
#pragma unroll
        for (int i = 0; i < 2; ++i) { oc0[i] = on0[i]; oc1[i] = on1[i]; }
        if constexpr (ALIGN_EPI) { if (wr == 1) PG8_BAR; }
    }
    if constexpr (Epi::DEFER) { if (have_pend) {
#pragma unroll
        for (int i = 0; i < 8; ++i) E.store_piece(pbase, i, pend[i]); } }
    PG8_WAIT_V(0);
    if constexpr (!ALIGN_EPI) { if (wr == 0) PG8_BAR; }
    PG8_BAR;
    if constexpr (Epi::AFTER_DRAIN) { E.fused(acc, cur, wr, wc, fr, fq, lds, wid, lane); S.done(cur); }
#undef PG8_SA
#undef PG8_SB
#undef PG8_STAGE
#undef PG8_LDA
#undef PG8_LDB
#undef PG8_MMA
#undef PG8_WAIT_V
#undef PG8_WAIT_L
#undef PG8_BAR
#undef PG8_SCHED
}

struct SchedDense {
    int nM, nN, nwg, G, c, mode; unsigned lda, ldb, acolb;
    __device__ __forceinline__ void init(int nM_, int nN_, int G_, int c_, int mode_, int lda_, int ldb_, int acolb_) { nM = nM_; nN = nN_; nwg = nM * nN; G = G_; c = c_; mode = mode_; lda = lda_; ldb = ldb_; acolb = acolb_; }
    __device__ __forceinline__ bool next(int i, Unit& u) const {
        const long L = (long)i * G + c; if (L >= nwg) return false;
        int wgid = (int)L; { const int q = nwg / NXCD, r = nwg % NXCD, xcd = wgid % NXCD, off = wgid / NXCD; wgid = (xcd < r ? xcd * (q + 1) : r * (q + 1) + (xcd - r) * q) + off; }
        const int nig = WGM * nN, gid = wgid / nig, fm = gid * WGM, gsz = (nM - fm) < WGM ? (nM - fm) : WGM;
        const int tm = fm + ((wgid % nig) % gsz); u.pn = (wgid % nig) / gsz;
        u.pm = mode ? (tm / 16) * TPB + 1 + (tm % 16) : tm; u.e = 0; u.x = u.pn; return true;
    }
    __device__ __forceinline__ size_t aoff(const Unit& u) const { return (size_t)u.pm * 256 * lda * 2 + (size_t)u.pn * acolb; }
    __device__ __forceinline__ size_t boff(const Unit& u) const { return (size_t)u.pn * 256 * ldb * 2; }
    __device__ __forceinline__ void a_ready(const Unit&) const {}
    __device__ __forceinline__ void done(const Unit&) const {}
};
struct SchedWin {
    int nM, nN, nwg, G, c; long dAB;
    __device__ __forceinline__ void init(int nM_, int G_, int c_, long dAB_) { nM = nM_; nN = 12; nwg = nM * nN; G = G_; c = c_; dAB = dAB_; }
    __device__ __forceinline__ bool next(int i, Unit& u) const {
        const long L = (long)i * G + c; if (L >= nwg) return false;
        int wgid = (int)L; { const int q = nwg / NXCD, r = nwg % NXCD, xcd = wgid % NXCD, off = wgid / NXCD; wgid = (xcd < r ? xcd * (q + 1) : r * (q + 1) + (xcd - r) * q) + off; }
        const int nig = WGM * nN, gid = wgid / nig, fm = gid * WGM, gsz = (nM - fm) < WGM ? (nM - fm) : WGM;
        u.pm = fm + ((wgid % nig) % gsz); u.pn = (wgid % nig) / gsz; u.e = u.pn < 6 ? 1 : 0; u.x = u.pn; return true;
    }
    __device__ __forceinline__ size_t aoff(const Unit& u) const { return u.e ? (size_t)(dAB + (long)u.pn * (256 * 1024 * 2)) : (size_t)u.pm * (256 * 1024 * 2); }
    __device__ __forceinline__ size_t boff(const Unit& u) const { return u.e ? (size_t)(-dAB + (long)u.pm * (256 * 1024 * 2)) : (size_t)u.pn * (256 * 1024 * 2); }
    __device__ __forceinline__ void a_ready(const Unit&) const {}
    __device__ __forceinline__ void done(const Unit&) const {}
};
struct SchedMoe {
    int nPm, nPn, per, G, c, slots, xcd, slot, W; unsigned lda, ldb; int cx;
    __device__ __forceinline__ void init(int nPm_, int nPn_, int G_, int c_, int lda_, int ldb_) { nPm = nPm_; nPn = nPn_; per = nPm * nPn; G = G_; c = c_; lda = lda_; ldb = ldb_; cx = 0;
        slots = G / NXCD; xcd = c % NXCD; slot = c / NXCD; W = nPn < 8 ? nPn : 8; }
    __device__ __forceinline__ bool next(int i, Unit& u) const {
        if (slots == 0) { const long L = (long)i * G + c; if (L >= NE * per) return false; const int e = (int)L / per, rem = (int)L % per; u.e = e; u.x = rem / nPm; u.pm = e * (ME / 256) + rem % nPm; u.pn = e * nPn + u.x; return true; }
        if (slot >= slots) return false;
        if (cx) { if (i > 0 || slot >= 16) return false; const int e = 2 * xcd + (slot >> 3), pnl = (slot >> 1) & 3, kh = slot & 1; u.e = e | (kh << 8); u.x = pnl; u.pm = e * (ME / 256) + (ME / 256 - 1); u.pn = e * nPn + pnl; return true; }
        const int q = i * slots + slot; if (q >= 2 * per) return false;
        const int e = 2 * xcd + q / per, rem = q % per, pnl = W * (rem / (W * nPm)) + rem % W, pml = (rem / W) % nPm;
        u.e = e; u.x = pnl; u.pm = e * (ME / 256) + pml; u.pn = e * nPn + pnl; return true;
    }
    __device__ __forceinline__ size_t aoff(const Unit& u) const { return (size_t)u.pm * 256 * lda * 2 + (size_t)(u.e >> 8) * (lda / 2) * 2; }
    __device__ __forceinline__ size_t boff(const Unit& u) const { return (size_t)u.pn * 256 * ldb * 2 + (size_t)(u.e >> 8) * (ldb / 2) * 2; }
    __device__ __forceinline__ void a_ready(const Unit&) const {}
    __device__ __forceinline__ void done(const Unit&) const {}
};

struct EpiWin {
    static constexpr bool PERM = true, AFTER_DRAIN = false, DEFER = false;
    bf16_t* P; bf16_t* PT; bf16_t* PTC; bf16_t* QB; bf16_t* KB; const float* qg; const float* kg; const PG8_LAS float* cs;
    __device__ __forceinline__ void operator()(const f32x4 (&acc)[2][2][4][2], const Unit& u, int wr, int wc, int fr, int fq) const {
        const int pn = __builtin_amdgcn_readfirstlane(u.pn);
        if (pn >= 6 && pn < 10) {
            const bool isq = pn < 8; bf16_t* OUT = isq ? QB : KB; const float* gg = (isq ? qg : kg) + 8 * fq;
            const int hm = (pn & 1) * 4 + wc, tt = u.pm % TPB; const bool lat = tt != 0, upper = fq >= 2;
            f32x4 g[2][2];
#pragma unroll
            for (int bj = 0; bj < 2; ++bj)
#pragma unroll
                for (int n = 0; n < 2; ++n) g[bj][n] = *(const f32x4*)(gg + 32 * bj + 4 * n);
            const float qs = isq ? 0.18033688011112042f : 1.f;
            const int fi0 = 8 * (fq & 1);
#pragma unroll
            for (int ai = 0; ai < 2; ++ai)
#pragma unroll
                for (int m = 0; m < 4; ++m) { const int rl = ai * HALF + wr * 64 + m * 16 + fr;
                    f32x4 x[2][2]; float ss = 0.f;
#pragma unroll
                    for (int bj = 0; bj < 2; ++bj)
#pragma unroll
                        for (int n = 0; n < 2; ++n) { x[bj][n] = acc[ai][bj][m][n]; ss += (x[bj][n][0] * x[bj][n][0] + x[bj][n][1] * x[bj][n][1]) + (x[bj][n][2] * x[bj][n][2] + x[bj][n][3] * x[bj][n][3]); }
                    ss += __shfl_xor(ss, 16); ss += __shfl_xor(ss, 32);
                    const float rstd = qs / sqrtf(ss * (1.f / 64.f) + 1e-6f);
#pragma unroll
                    for (int bj = 0; bj < 2; ++bj)
#pragma unroll
                        for (int n = 0; n < 2; ++n) x[bj][n] = x[bj][n] * rstd * g[bj][n];
                    if (lat) { const int t = (tt - 1) * 256 + rl;
#pragma unroll
                        for (int bj = 0; bj < 2; ++bj) { const PG8_LAS float* cp = cs + (bj ? (t & 63) : (t >> 6)) * 16 + fi0;
#pragma unroll
                            for (int n = 0; n < 2; ++n) { const f32x4 c4 = *(const PG8_LAS f32x4*)(cp + 4 * n), s4 = *(const PG8_LAS f32x4*)(cp + 1024 + 4 * n);
#pragma unroll
                                for (int j = 0; j < 4; ++j) { const unsigned own = __float_as_uint(x[bj][n][j]); auto rr = __builtin_amdgcn_permlane32_swap(own, own, false, false);
                                    const float other = __uint_as_float(rr[0] ^ rr[1] ^ own);
                                    x[bj][n][j] = upper ? (other * s4[j] + x[bj][n][j] * c4[j]) : (x[bj][n][j] * c4[j] - other * s4[j]); } } } }
                    bf16_t* op = OUT + (size_t)(u.pm * 256 + rl) * 512 + hm * 64 + 8 * fq;
#pragma unroll
                    for (int bj = 0; bj < 2; ++bj) { u32x4 w; w.x = cvt_pk_bf16(x[bj][0][0], x[bj][0][1]); w.y = cvt_pk_bf16(x[bj][0][2], x[bj][0][3]); w.z = cvt_pk_bf16(x[bj][1][0], x[bj][1][1]); w.w = cvt_pk_bf16(x[bj][1][2], x[bj][1][3]);
                        *(u32x4*)(op + 32 * bj) = w; } }
            return;
        }
        bf16_t* base; size_t rstride;
        if (pn < 6) { const int part = pn >> 1, b = u.pm / TPB, tt = u.pm % TPB, c0 = (pn & 1) * 256 + wr * 64 + fr, tl = wc * 32 + 8 * fq;
            if (tt == 0) { rstride = CTX; base = PTC + ((size_t)(part * NB + b) * 512 + c0) * CTX + tl; }
            else { rstride = SEQ; base = PT + ((size_t)(part * NB + b) * 512 + c0) * SEQ + (tt - 1) * 256 + tl; }
        } else { rstride = 512; base = P + (size_t)5 * ((size_t)MT * 512) + (pn & 1) * 256 + wc * 32 + 8 * fq + (size_t)(u.pm * 256 + wr * 64 + fr) * 512; }
#pragma unroll
        for (int ai = 0; ai < 2; ++ai)
#pragma unroll
            for (int m = 0; m < 4; ++m) { bf16_t* rowp = base + (size_t)(ai * HALF + m * 16) * rstride;
#pragma unroll
                for (int bj = 0; bj < 2; ++bj) { const f32x4 v0 = acc[ai][bj][m][0], v1 = acc[ai][bj][m][1]; u32x4 w; w.x = cvt_pk_bf16(v0[0], v0[1]); w.y = cvt_pk_bf16(v0[2], v0[3]); w.z = cvt_pk_bf16(v1[0], v1[1]); w.w = cvt_pk_bf16(v1[2], v1[3]);
                    *(u32x4*)(rowp + bj * HALF) = w; } }
    }
};
struct EpiResid {
    static constexpr bool PERM = true, AFTER_DRAIN = false, DEFER = false;
    h16_t* H; const float* mods_l;
    const float* scale; float dry;
    const float* xin; const float* cin;
    __device__ __forceinline__ void operator()(const f32x4 (&acc)[2][2][4][2], const Unit& u, int wr, int wc, int fr, int fq) const {
        const int b = u.pm / TPB, bb = (u.pm % TPB == 0) ? 8 : b;
        const int col0 = u.x * 256 + wc * 32 + 8 * fq;
        const float* gp = mods_l + (size_t)bb * 6144 + 2 * 1024 + col0;
        h16_t* dbase = H + (size_t)u.pm * 256 * DM;
        const float* sbase = xin ? ((u.pm % TPB == 0) ? cin + (size_t)b * CTX * DM : xin + ((size_t)b * SEQ + (u.pm % TPB - 1) * 256) * DM) : nullptr;
        f32x4 gv[2][2];
#pragma unroll
        for (int bj = 0; bj < 2; ++bj)
#pragma unroll
            for (int n = 0; n < 2; ++n) { gv[bj][n] = *(const f32x4*)(gp + bj * HALF + n * 4) * dry; if (scale) gv[bj][n] = gv[bj][n] * *(const f32x4*)(scale + col0 + bj * HALF + n * 4); }
#pragma unroll
        for (int ai = 0; ai < 2; ++ai)
#pragma unroll
            for (int m = 0; m < 4; ++m) { const unsigned off = (unsigned)(wr * 64 + fr + ai * HALF + m * 16) * DM + (unsigned)col0;
#pragma unroll
                for (int bj = 0; bj < 2; ++bj) { f32x4 s0, s1;
                    if (sbase) { s0 = *(const f32x4*)(sbase + off + bj * HALF); s1 = *(const f32x4*)(sbase + off + bj * HALF + 4); }
                    else { const u32x4 w = *(const u32x4*)(dbase + off + bj * HALF); s0 = h4_f32((u32x2){w.x, w.y}); s1 = h4_f32((u32x2){w.z, w.w}); }
                    const u32x2 o0 = f32_h4(s0 + gv[bj][0] * acc[ai][bj][m][0]), o1 = f32_h4(s1 + gv[bj][1] * acc[ai][bj][m][1]);
                    *(u32x4*)(dbase + off + bj * HALF) = (u32x4){o0.x, o0.y, o1.x, o1.y}; } }
    }
};
struct EpiSwiglu {
    static constexpr bool PERM = true, AFTER_DRAIN = false, DEFER = false;
    bf16_t* ACT;
    __device__ __forceinline__ void operator()(const f32x4 (&acc)[2][2][4][2], const Unit& u, int wr, int wc, int fr, int fq) const {
        const int row0 = u.pm * 256 + wr * 64 + fr, col0 = u.x * 128 + wc * 32 + 8 * fq;
#pragma unroll
        for (int ai = 0; ai < 2; ++ai)
#pragma unroll
            for (int m = 0; m < 4; ++m) { bf16_t* rowp = ACT + (size_t)(row0 + ai * HALF + m * 16) * FF + col0; f32x4 v[2];
#pragma unroll
                for (int n = 0; n < 2; ++n) { const f32x4 g = acc[ai][0][m][n], up = acc[ai][1][m][n];
#pragma unroll
                    for (int j = 0; j < 4; ++j) v[n][j] = g[j] * __builtin_amdgcn_rcpf(1.f + __builtin_amdgcn_exp2f(g[j] * -1.4426950408889634f)) * up[j]; }
                u32x4 w; w.x = cvt_pk_bf16(v[0][0], v[0][1]); w.y = cvt_pk_bf16(v[0][2], v[0][3]); w.z = cvt_pk_bf16(v[1][0], v[1][1]); w.w = cvt_pk_bf16(v[1][2], v[1][3]);
                *(u32x4*)rowp = w; }
    }
};
struct EpiSwigluDefer {
    static constexpr bool PERM = true, AFTER_DRAIN = false, DEFER = true;
    bf16_t* ACT;
    __device__ __forceinline__ bf16_t* pack(const f32x4 (&acc)[2][2][4][2], const Unit& u, int wr, int wc, int fr, int fq, u32x4 (&pend)[8]) const {
        const int row0 = u.pm * 256 + wr * 64 + fr, col0 = u.x * 128 + wc * 32 + 8 * fq;
#pragma unroll
        for (int ai = 0; ai < 2; ++ai)
#pragma unroll
            for (int m = 0; m < 4; ++m) { f32x4 v[2];
#pragma unroll
                for (int n = 0; n < 2; ++n) { const f32x4 g = acc[ai][0][m][n], up = acc[ai][1][m][n];
#pragma unroll
                    for (int j = 0; j < 4; ++j) v[n][j] = g[j] * __builtin_amdgcn_rcpf(1.f + __builtin_amdgcn_exp2f(g[j] * -1.4426950408889634f)) * up[j]; }
                u32x4 w; w.x = cvt_pk_bf16(v[0][0], v[0][1]); w.y = cvt_pk_bf16(v[0][2], v[0][3]); w.z = cvt_pk_bf16(v[1][0], v[1][1]); w.w = cvt_pk_bf16(v[1][2], v[1][3]);
                pend[ai * 4 + m] = w; }
        return ACT + (size_t)row0 * FF + col0;
    }
    __device__ __forceinline__ void store_piece(bf16_t* base, int i, const u32x4& w) const { *(u32x4*)(base + (size_t)((i >> 2) * HALF + (i & 3) * 16) * FF) = w; }
    __device__ __forceinline__ void operator()(const f32x4 (&acc)[2][2][4][2], const Unit& u, int wr, int wc, int fr, int fq) const {}
};
struct EpiDown {
    static constexpr bool PERM = true, AFTER_DRAIN = false, DEFER = false;
    bf16_t* YP; const float* PG; bf16_t* YP2;
    __device__ __forceinline__ void operator()(const f32x4 (&acc)[2][2][4][2], const Unit& u, int wr, int wc, int fr, int fq) const {
        const int row0 = u.pm * 256 + wr * 64 + fr, col0 = u.x * 256 + wc * 32 + 8 * fq;
        bf16_t* Y = (u.e >> 8) ? YP2 + ((long)(u.e & 255) * 256 - (long)u.pm * 256) * DM : YP;
#pragma unroll
        for (int ai = 0; ai < 2; ++ai)
#pragma unroll
            for (int m = 0; m < 4; ++m) { const int row = row0 + ai * HALF + m * 16; const float gt = PG[row]; bf16_t* rowp = Y + (long)row * DM + col0;
#pragma unroll
                for (int bj = 0; bj < 2; ++bj) { const f32x4 v0 = acc[ai][bj][m][0] * gt, v1 = acc[ai][bj][m][1] * gt; u32x4 w; w.x = cvt_pk_bf16(v0[0], v0[1]); w.y = cvt_pk_bf16(v0[2], v0[3]); w.z = cvt_pk_bf16(v1[0], v1[1]); w.w = cvt_pk_bf16(v1[2], v1[3]);
                    *(u32x4*)(rowp + bj * HALF) = w; } }
    }
};
struct EpiNull { static constexpr bool PERM = true, AFTER_DRAIN = false, DEFER = false; int dummy;
    __device__ __forceinline__ void operator()(const f32x4 (&acc)[2][2][4][2], const Unit& u, int wr, int wc, int fr, int fq) const {
#pragma unroll
        for (int ai = 0; ai < 2; ++ai)
#pragma unroll
            for (int bj = 0; bj < 2; ++bj)
#pragma unroll
                for (int m = 0; m < 4; ++m)
#pragma unroll
                    for (int n = 0; n < 2; ++n) { f32x4 t = acc[ai][bj][m][n]; asm volatile("" :: "v"(t)); } } };
}

namespace att {
constexpr int D = 128, NW = 8, QBLK = 32, KVBLK = 64;
constexpr int LDQ = 512, LDK = 512, LDO = 512;
constexpr int NBUF = 4;
constexpr size_t SHM_V = KVBLK * D * 2, SHM_K = KVBLK * D * 2, SHM_ATTN = NBUF * SHM_V + NBUF * SHM_K + NW * 64 * 4;
#define KSWZ(row, colB) ((row) * 256 + ((colB) ^ (((row) & 7) << 4)))
#define SBAR() __builtin_amdgcn_sched_barrier(0)
__device__ __forceinline__ int crow(int r, int hi) { return (r & 3) + 8 * (r >> 2) + 4 * hi; }
__device__ __forceinline__ unsigned cvtpk(float lo, float hi) { unsigned r; asm volatile("v_cvt_pk_bf16_f32 %0, %1, %2" : "=v"(r) : "v"(lo), "v"(hi)); return r; }
__device__ __forceinline__ bf16x8 ld8(const bf16_t* p) { return *reinterpret_cast<const bf16x8*>(p); }

__device__ __forceinline__ void partialSM(f32x16& p0, f32x16& p1, float nb) {
#pragma unroll
  for (int r = 0; r < 16; ++r) p0[r] = __builtin_amdgcn_exp2f(p0[r]);
}
__device__ __forceinline__ void finishSM(f32x16& p0, f32x16& p1, float nb, float& l_reg, bf16x8& pa0, bf16x8& pa1, bf16x8& pa2, bf16x8& pa3) {
#pragma unroll
  for (int r = 0; r < 16; ++r) p1[r] = __builtin_amdgcn_exp2f(p1[r]);
  f32x2 s2 = (f32x2){p0[0], p0[1]} + (f32x2){p1[0], p1[1]};
#pragma unroll
  for (int r = 2; r < 16; r += 2) { s2 = s2 + (f32x2){p0[r], p0[r + 1]}; s2 = s2 + (f32x2){p1[r], p1[r + 1]}; }
  float ps = s2[0] + s2[1];
  { auto rr = __builtin_amdgcn_permlane32_swap(__float_as_uint(ps), __float_as_uint(ps), false, false);
    ps = __uint_as_float(rr[0]) + __uint_as_float(rr[1]); }
  l_reg += ps;
#define PK4(P, BASE, OUT) do { u32x4 w = {cvtpk(P[BASE + 0], P[BASE + 1]), cvtpk(P[BASE + 2], P[BASE + 3]), cvtpk(P[BASE + 4], P[BASE + 5]), cvtpk(P[BASE + 6], P[BASE + 7])}; \
    OUT = *reinterpret_cast<bf16x8*>(&w); } while (0)
  PK4(p0, 0, pa0); PK4(p0, 8, pa1); PK4(p1, 0, pa2); PK4(p1, 8, pa3);
#undef PK4
}
__device__ __forceinline__ void qkt(f32x16& p0, f32x16& p1, const __attribute__((address_space(3))) char* Ks, const bf16x8* qr, int r32, int hi, int mc, const f32x16& negm) {
  bf16x8 kf[8];
#pragma unroll
  for (int d0 = 0; d0 < 4; ++d0) { const int cb = (mc + d0 * 16 + hi * 8) * 2;
    kf[2 * d0] = *(const __attribute__((address_space(3))) bf16x8*)(Ks + KSWZ(r32, cb)); kf[2 * d0 + 1] = *(const __attribute__((address_space(3))) bf16x8*)(Ks + KSWZ(32 + r32, cb)); }
#pragma unroll
  for (int d0 = 0; d0 < 4; ++d0) {
    p0 = __builtin_amdgcn_mfma_f32_32x32x16_bf16(kf[2 * d0], qr[d0], d0 == 0 ? negm : p0, 0, 0, 0);
    p1 = __builtin_amdgcn_mfma_f32_32x32x16_bf16(kf[2 * d0 + 1], qr[d0], d0 == 0 ? negm : p1, 0, 0, 0); }
}
__device__ __forceinline__ int v_st(int k, int c) { const int kk = (k & ~0xC) | ((k & 4) << 1) | ((k & 8) >> 1); return ((kk >> 3) * 4 + (c >> 5)) * 512 + ((kk & 7) * 32 + (c & 31)) * 2; }
__device__ __forceinline__ int v_rd_base(int lane) { return ((lane & 3) << 3) | (((lane >> 2) & 3) << 6) | (((lane >> 4) & 1) << 5) | (((lane >> 5) & 1) << 8); }
constexpr int v_rd_off(int d0, int ks, int half) { return d0 * 512 + ks * 4096 + half * 2048; }
template <int OFF> __device__ __forceinline__ s16x4 tr_read(int vb) {
  s16x4 r; asm volatile("ds_read_b64_tr_b16 %0, %1 offset:%2" : "=&v"(r) : "v"(vb), "i"(OFF) : "memory"); return r;
}
template <int D0, int SO> __device__ __forceinline__ void pv_one(f32x16& od, int vb, bf16x8 pa0, bf16x8 pa1, bf16x8 pa2, bf16x8 pa3) {
  const s16x4 l0 = tr_read<SO + v_rd_off(D0, 0, 0)>(vb), h0 = tr_read<SO + v_rd_off(D0, 0, 1)>(vb), l1 = tr_read<SO + v_rd_off(D0, 1, 0)>(vb), h1 = tr_read<SO + v_rd_off(D0, 1, 1)>(vb);
  const s16x4 l2 = tr_read<SO + v_rd_off(D0, 2, 0)>(vb), h2 = tr_read<SO + v_rd_off(D0, 2, 1)>(vb), l3 = tr_read<SO + v_rd_off(D0, 3, 0)>(vb), h3 = tr_read<SO + v_rd_off(D0, 3, 1)>(vb);
  asm volatile("s_waitcnt lgkmcnt(0)" ::: "memory"); SBAR();
#define PK(L, H) (bf16x8){L[0], L[1], L[2], L[3], H[0], H[1], H[2], H[3]}
  od = __builtin_amdgcn_mfma_f32_32x32x16_bf16(pa0, PK(l0, h0), od, 0, 0, 0);
  od = __builtin_amdgcn_mfma_f32_32x32x16_bf16(pa1, PK(l1, h1), od, 0, 0, 0);
  od = __builtin_amdgcn_mfma_f32_32x32x16_bf16(pa2, PK(l2, h2), od, 0, 0, 0);
  od = __builtin_amdgcn_mfma_f32_32x32x16_bf16(pa3, PK(l3, h3), od, 0, 0, 0);
#undef PK
}
template <int SO = 0> __device__ __forceinline__ void pv_d0(f32x16* o, int vb, bf16x8 pa0, bf16x8 pa1, bf16x8 pa2, bf16x8 pa3) {
  pv_one<0, SO>(o[0], vb, pa0, pa1, pa2, pa3); pv_one<1, SO>(o[1], vb, pa0, pa1, pa2, pa3); pv_one<2, SO>(o[2], vb, pa0, pa1, pa2, pa3); pv_one<3, SO>(o[3], vb, pa0, pa1, pa2, pa3);
}

__device__ __forceinline__ void attn_unit(const bf16_t* __restrict__ Qb, const bf16_t* __restrict__ Kh, const bf16_t* __restrict__ Vh, bf16_t* __restrict__ Ob, float lam, float outscale, const float* __restrict__ subg, float negbound, int seq, char* lds) {
  int tid = threadIdx.x; asm volatile("" : "+v"(tid)); const int wid = tid >> 6, lane = tid & 63, r32 = lane & 31, hi = lane >> 5;
  const int mp = wid >> 2, wq = wid & 3, mc = mp * 64;
  bf16_t* V_lds = (bf16_t*)lds; bf16_t* K_lds = (bf16_t*)(lds + NBUF * SHM_V);
  float* ws = (float*)(lds + NBUF * SHM_V + NBUF * SHM_K) + wid * 64; float* li_l = ws;
  float l_reg = 0; f32x16 o[4] = {}; bf16x8 qr[4];
  f32x16 negm;
#pragma unroll
  for (int r = 0; r < 16; ++r) negm[r] = negbound;
  const bf16_t* Qw = Qb + (long)(wq * QBLK + r32) * LDQ + mc + hi * 8;
#pragma unroll
  for (int d0 = 0; d0 < 4; ++d0) qr[d0] = ld8(Qw + d0 * 16);
  const int vb0 = (int)(uintptr_t)V_lds + v_rd_base(lane);
  const unsigned lds0 = (unsigned)(uintptr_t)lds;
  unsigned ksrc[2], vsrc[2];
#pragma unroll
  for (int i = 0; i < 2; ++i) { const int c = wid * 2 + i;
    { const int row = c * 4 + (lane >> 4), colB = ((lane & 15) << 4) ^ ((row & 7) << 4); ksrc[i] = (unsigned)(row * (LDK * 2) + colB); }
    { const int sub = c * 2 + (lane >> 5), kk = (sub >> 2) * 8 + ((lane & 31) >> 2), k = kk, col = (sub & 3) * 32 + (lane & 3) * 8;
      vsrc[i] = (unsigned)(k * (LDK * 2) + col * 2); } }
  const unsigned kdst = (unsigned)__builtin_amdgcn_readfirstlane(lds0 + NBUF * (unsigned)SHM_V + wid * 2048), vdst = (unsigned)__builtin_amdgcn_readfirstlane(lds0 + wid * 2048);
  const unsigned ks1m = ksrc[1] - 1024u, vs0p = vsrc[0] + 1024u; const char* Vhm = (const char*)Vh - 1024;
#define DMA_TILE(t) do { const size_t go_ = (size_t)(t) * (KVBLK * LDK * 2); const unsigned bo_ = (unsigned)(((t) & 3) * (int)SHM_V); const char* kb_ = (const char*)Kh + go_; const char* vb_ = Vhm + go_; \
    asm volatile("s_mov_b32 m0, %4\n\ts_nop 0\n\tglobal_load_lds_dwordx4 %0, %2\n\tglobal_load_lds_dwordx4 %1, %2 offset:1024\n\ts_mov_b32 m0, %5\n\ts_nop 0\n\tglobal_load_lds_dwordx4 %6, %3\n\tglobal_load_lds_dwordx4 %7, %3 offset:1024" \
        :: "v"(ksrc[0]), "v"(ks1m), "s"(kb_), "s"(vb_), "s"(kdst + bo_), "s"(vdst + bo_), "v"(vs0p), "v"(vsrc[1]) : "memory", "m0"); } while (0)
#define WAITBAR(N) asm volatile("s_waitcnt vmcnt(" #N ") lgkmcnt(0)\n\ts_barrier" ::: "memory")
#define BOFF(t) (((t) & 3) * (int)SHM_V)
  f32x16 pA0, pA1, pB0, pB1; bf16x8 pa0, pa1, pa2, pa3; const int NT = seq / KVBLK;
  DMA_TILE(0); DMA_TILE(1);
  WAITBAR(0);
  if (2 < NT) DMA_TILE(2);
  const __attribute__((address_space(3))) char* K3 = (const __attribute__((address_space(3))) char*)K_lds;
  qkt(pA0, pA1, K3, qr, r32, hi, mc, negm); partialSM(pA0, pA1, negbound);
#define STEP_CT(t, KS, VS, PQ0, PQ1, PP0, PP1) do { if ((t) + 2 < NT) DMA_TILE((t) + 2); \
    SBAR(); qkt(PQ0, PQ1, K3 + (KS) * (int)SHM_K, qr, r32, hi, mc, negm); finishSM(PP0, PP1, negbound, l_reg, pa0, pa1, pa2, pa3); SBAR(); \
    pv_d0<(VS) * (int)SHM_V>(o, vb0, pa0, pa1, pa2, pa3); partialSM(PQ0, PQ1, negbound); \
    if ((t) + 2 < NT) WAITBAR(4); else WAITBAR(0); } while (0)
  int j = 1;
  for (; j + 3 < NT; j += 4) {
    STEP_CT(j, 1, 0, pB0, pB1, pA0, pA1); STEP_CT(j + 1, 2, 1, pA0, pA1, pB0, pB1); STEP_CT(j + 2, 3, 2, pB0, pB1, pA0, pA1); STEP_CT(j + 3, 0, 3, pA0, pA1, pB0, pB1);
  }
  STEP_CT(j, 1, 0, pB0, pB1, pA0, pA1); STEP_CT(j + 1, 2, 1, pA0, pA1, pB0, pB1);
#undef STEP_CT
  SBAR(); qkt(pB0, pB1, K3 + 3 * (int)SHM_K, qr, r32, hi, mc, negm);
  finishSM(pA0, pA1, negbound, l_reg, pa0, pa1, pa2, pa3); SBAR();
  pv_d0<2 * (int)SHM_V>(o, vb0, pa0, pa1, pa2, pa3); partialSM(pB0, pB1, negbound);
  finishSM(pB0, pB1, negbound, l_reg, pa0, pa1, pa2, pa3); SBAR();
  pv_d0<3 * (int)SHM_V>(o, vb0, pa0, pa1, pa2, pa3);
#undef DMA_TILE
#undef WAITBAR
#undef BOFF
  if (hi == 0) li_l[r32] = l_reg; asm volatile("s_waitcnt lgkmcnt(0)" ::: "memory");
  float rli[16];
#pragma unroll
  for (int r = 0; r < 16; ++r) rli[r] = __builtin_amdgcn_rcpf(li_l[crow(r, hi)]);
#pragma unroll
  for (int d0 = 0; d0 < 4; ++d0)
#pragma unroll
    for (int r = 0; r < 16; ++r) o[d0][r] *= rli[r];
  __syncthreads();
  float* X = (float*)lds + wq * 4096;
  if (mp == 1) {
#pragma unroll
    for (int d0 = 0; d0 < 4; ++d0)
#pragma unroll
      for (int r = 0; r < 16; ++r) X[(d0 * 16 + r) * 64 + lane] = o[d0][r]; }
  __syncthreads();
  if (mp == 0) {
    float ss[16];
#pragma unroll
    for (int r = 0; r < 16; ++r) ss[r] = 0.f;
#pragma unroll
    for (int d0 = 0; d0 < 4; ++d0)
#pragma unroll
      for (int r = 0; r < 16; ++r) { const float d = o[d0][r] - lam * X[(d0 * 16 + r) * 64 + lane]; o[d0][r] = d; ss[r] = fmaf(d, d, ss[r]); }
#pragma unroll
    for (int r = 0; r < 16; ++r) { float s = ss[r]; s += __shfl_xor(s, 1); s += __shfl_xor(s, 2); s += __shfl_xor(s, 4); s += __shfl_xor(s, 8); s += __shfl_xor(s, 16);
      ss[r] = outscale / sqrtf(s * (1.f / 128.f) + 1e-6f); }
    bf16_t* Ow = Ob + (long)(wq * QBLK) * 1024;
#pragma unroll
    for (int d0 = 0; d0 < 4; ++d0) { const float gcol = subg[d0 * 32 + r32];
#pragma unroll
      for (int r = 0; r < 16; ++r) { const unsigned w = cvtpk(o[d0][r] * ss[r] * gcol, 0.f); Ow[(long)crow(r, hi) * 1024 + d0 * 32 + r32] = (bf16_t)(w & 0xffffu); } }
  }
  __syncthreads();
}
#undef KSWZ
#undef SBAR
}

struct Params { const float* in[31]; float* out; unsigned char* ws; int ph_lo, ph_hi; };
enum { I_X = 0, I_C, I_CTX, I_CCTX, I_ADAW, I_ADAB, I_NMG, I_NFG, I_WIN, I_WOUT, I_CONVW, I_CONVB, I_FW1, I_FB1, I_FW2, I_FB2, I_FW3, I_FB3, I_FFREQ, I_FWOUT, I_HYBIAS,
       I_QG, I_KG, I_LAMBDA, I_SUBLN, I_POOLW, I_POOLS, I_ROUTER, I_WGATE, I_WUP, I_WDOWN };
typedef const float* cfptr_t;
typedef __attribute__((address_space(4))) const cfptr_t* katab_t;
struct Frame {
    char* lds; int tid, lane, wave, G, bid, gw, NGW;
    katab_t in; unsigned char* ws;
};
#define WSP(T, off) ((T*)(F.ws + (off)))
__device__ __forceinline__ bool moe_split(int G) { return G % 8 == 0 && G / 8 >= 16; }

constexpr int TR_LDS = 64 * 65 * 4;
__device__ __forceinline__ void tr_load(f32x4 (&v)[16], const float* W, int N, int k0, int n0, int lane) {
    const int kr = lane >> 4, nc = lane & 15;
#pragma unroll
    for (int i = 0; i < 16; ++i) v[i] = __builtin_nontemporal_load((const f32x4*)(W + (size_t)(k0 + 4 * i + kr) * N + n0 + 4 * nc));
}
__device__ __forceinline__ void tr_store(const f32x4 (&v)[16], bf16_t* WT, int ldt, int k0, int orow0, float* scr, int lane, int hi_off = 0) {
    const int kr = lane >> 4, nc = lane & 15;
#pragma unroll
    for (int i = 0; i < 16; ++i) { float* d = scr + (4 * i + kr) * 65 + 4 * nc; d[0] = v[i][0]; d[1] = v[i][1]; d[2] = v[i][2]; d[3] = v[i][3]; }
    LDS_WAIT(); asm volatile("" ::: "memory");
    const int nl = lane >> 3, kc = lane & 7;
#pragma unroll
    for (int j = 0; j < 8; ++j) { const int n = nl + 8 * j; const float* s = scr + (8 * kc) * 65 + n;
        u32x4 o; o.x = cvt_pk_bf16(s[0 * 65], s[1 * 65]); o.y = cvt_pk_bf16(s[2 * 65], s[3 * 65]); o.z = cvt_pk_bf16(s[4 * 65], s[5 * 65]); o.w = cvt_pk_bf16(s[6 * 65], s[7 * 65]);
        __builtin_nontemporal_store(o, (u32x4*)(WT + (size_t)(orow0 + n + (j >= 4 ? hi_off : 0)) * ldt + k0 + 8 * kc)); }
    LDS_WAIT(); asm volatile("" ::: "memory");
}
__device__ __forceinline__ void transpose_item(const float* W, int N, bf16_t* WT, int ldt, int k0, int n0, int orow0, float* scr, int lane, int hi_off = 0) {
    f32x4 v[16]; tr_load(v, W, N, k0, n0, lane); tr_store(v, WT, ldt, k0, orow0, scr, lane, hi_off);
}
__device__ __forceinline__ void cvt_matrix(Frame& F, const float* W, int K, int N, bf16_t* WT, int ldt, int orow_base) {
    float* scr = (float*)(F.lds + F.wave * TR_LDS);
    const int nblk = N / 64, nitems = (K / 64) * nblk;
    for (int it = F.gw; it < nitems; it += F.NGW) { const int kb = it / nblk, nb = it % nblk; transpose_item(W, N, WT, ldt, kb * 64, nb * 64, orow_base + nb * 64, scr, F.lane); }
}

__device__ __forceinline__ void norm_mod_store(const f32x4 (&v)[4], float rstd, const float* g, const float* sc, const float* sh, bf16_t* orow, int lane) {
#pragma unroll
    for (int j = 0; j < 4; ++j) { const int col = 4 * lane + 256 * j;
        const f32x4 gg = *(const f32x4*)(g + col), s1 = *(const f32x4*)(sc + col), s0 = *(const f32x4*)(sh + col);
        f32x4 y = v[j] * rstd * gg * (s1 + 1.f) + s0;
        u32x2 w; w.x = cvt_pk_bf16(y[0], y[1]); w.y = cvt_pk_bf16(y[2], y[3]); st8(orow + col, w); }
}
__device__ __forceinline__ float row_rstd(const f32x4 (&v)[4]) {
    float s = 0.f;
#pragma unroll
    for (int j = 0; j < 4; ++j) s += (v[j][0] * v[j][0] + v[j][1] * v[j][1]) + (v[j][2] * v[j][2] + v[j][3] * v[j][3]);
    return 1.f / sqrtf(wave_sum(s) * (1.f / DM) + NORM_EPS);
}
__device__ __forceinline__ int row_bb(int r) { const int b = r / RPB, j = r - b * RPB; return j < CTX ? 8 : b; }

__device__ __forceinline__ void ph_mods(Frame& F) {
    float* s = (float*)F.lds; float* red = s + 9 * 1024;
    const float* c = F.in[I_C]; const float* cc = F.in[I_CCTX]; const float* aw = F.in[I_ADAW]; const float* ab = F.in[I_ADAB]; float* MODS = WSP(float, WS_MODS);
    const int m0 = F.G >= 200 ? 132 : 0, mstep = F.G - m0;
    if (F.bid < m0 || F.bid - m0 >= 4 * 48) return;
    for (int i = F.tid; i < 9 * 1024; i += NTHR) { const int bb = i >> 10, k = i & 1023; const float xv = bb < 8 ? c[bb * 1024 + k] : cc[k]; s[i] = xv / (1.f + expf(-xv)); }
    __syncthreads();
    for (int item = F.bid - m0; item < 4 * 48; item += mstep) {
        const int l = item / 48, cb = item % 48, colc = F.tid & 127, kq = F.tid >> 7;
        const float* W = aw + ((size_t)l * 1024 + kq * 256) * 6144 + cb * 128 + colc;
        float acc[9];
#pragma unroll
        for (int bb = 0; bb < 9; ++bb) acc[bb] = 0.f;
#pragma unroll 32
        for (int k = 0; k < 256; ++k) { const float w = W[(size_t)k * 6144];
#pragma unroll
            for (int bb = 0; bb < 9; ++bb) acc[bb] = fmaf(s[bb * 1024 + kq * 256 + k], w, acc[bb]); }
#pragma unroll
        for (int bb = 0; bb < 9; ++bb) red[(kq * 9 + bb) * 128 + colc] = acc[bb];
        __syncthreads();
        for (int i = F.tid; i < 9 * 128; i += NTHR) { const int bb = i >> 7, c2 = i & 127;
            const float v = (red[(0 * 9 + bb) * 128 + c2] + red[(1 * 9 + bb) * 128 + c2]) + (red[(2 * 9 + bb) * 128 + c2] + red[(3 * 9 + bb) * 128 + c2]) + ab[l * 6144 + cb * 128 + c2];
            MODS[((size_t)l * 9 + bb) * 6144 + cb * 128 + c2] = v; }
        __syncthreads();
    }
}
__device__ __forceinline__ void ph_cvt_small(Frame& F) {
    for (int e = 0; e < 2; ++e) {
        {
          float* scr = (float*)(F.lds + F.wave * TR_LDS); const float* W = F.in[I_WIN] + (size_t)e * 1024 * 3072; bf16_t* WT = WSP(bf16_t, WS_WINT) + (size_t)e * 3072 * 1024;
          for (int it = F.gw; it < 16 * 48; it += F.NGW) { const int kb = it / 48, nb = it % 48, n0 = nb * 64; int orow0 = n0, hi = 0;
              if (n0 >= 1536 && n0 < 2560) { const int r = n0 - 1536; orow0 = 1536 + (r & ~255) + 32 * ((r & 255) >> 6); hi = 96; }
              transpose_item(W, 3072, WT, 1024, kb * 64, n0, orow0, scr, F.lane, hi); } }
        cvt_matrix(F, F.in[I_WOUT] + (size_t)e * 1024 * 1024, 1024, 1024, WSP(bf16_t, WS_WOUTT) + (size_t)e * 1024 * 1024, 1024, 0);
        for (int gi = 0; gi < 4; ++gi) cvt_matrix(F, F.in[I_POOLW] + ((size_t)e * 4 + gi) * 256 * 256, 256, 256, WSP(bf16_t, WS_POOLT) + (size_t)e * 1024 * 256, 256, gi * 256);
    }
}
struct CvtItem { const float* W; bf16_t* WT; int N, ldt, k0, n0, orow0; };
__device__ __forceinline__ CvtItem cvt_expert_item(int it, const float* wg, const float* wu, const float* wd, bf16_t* W13, bf16_t* W2) {
    constexpr int PER = 512;
    const int e = it / (3 * PER), r = it % (3 * PER), which = r / PER, q = r % PER; CvtItem c;
    if (which < 2) { const int nb = q / 16, kb = q % 16, n0 = nb * 64;
        c.W = (which ? wu : wg) + (size_t)e * 1024 * 2048; c.N = 2048; c.WT = W13 + (size_t)e * 4096 * 1024; c.ldt = 1024; c.k0 = kb * 64; c.n0 = n0; c.orow0 = (n0 >> 7) * 256 + (n0 & 127) + which * 128;
    } else { const int nb = q / 32, kb = q % 32;
        c.W = wd + (size_t)e * 2048 * 1024; c.N = 1024; c.WT = W2 + (size_t)e * 1024 * 2048; c.ldt = 2048; c.k0 = kb * 64; c.n0 = nb * 64; c.orow0 = nb * 64; }
    return c;
}
__device__ __forceinline__ void ph_cvt_experts(Frame& F, int l) {
    float* scr = (float*)(F.lds + F.wave * TR_LDS);
    const float* wg = F.in[I_WGATE] + (size_t)l * NE * 1024 * 2048; const float* wu = F.in[I_WUP] + (size_t)l * NE * 1024 * 2048; const float* wd = F.in[I_WDOWN] + (size_t)l * NE * 2048 * 1024;
    bf16_t* W13 = (bf16_t*)(F.ws + WS_W13T + (size_t)(l & 1) * W13T_BYTES); bf16_t* W2 = (bf16_t*)(F.ws + WS_W2T + (size_t)(l & 1) * W2T_BYTES);
    constexpr int NIT = NE * 3 * 512;
    const int per = (NIT + F.NGW - 1) / F.NGW, itend = min(NIT, (F.gw + 1) * per);
#ifndef CVT_NREP
#define CVT_NREP 1
#endif
    int nrep = CVT_NREP; asm volatile("" : "+s"(nrep));
    for (int rep = 0; rep < nrep; ++rep) {
    int it = F.gw * per; if (it >= itend) return;
    f32x4 va[16], vb[16];
    CvtItem ca = cvt_expert_item(it, wg, wu, wd, W13, W2), cb = ca; tr_load(va, ca.W, ca.N, ca.k0, ca.n0, F.lane);
    for (;;) {
        int nit = it + 1; bool more = nit < itend;
        if (more) { cb = cvt_expert_item(nit, wg, wu, wd, W13, W2); tr_load(vb, cb.W, cb.N, cb.k0, cb.n0, F.lane); }
        tr_store(va, ca.WT, ca.ldt, ca.k0, ca.orow0, scr, F.lane);
        if (!more) break;
        it = nit; nit = it + 1; more = nit < itend;
        if (more) { ca = cvt_expert_item(nit, wg, wu, wd, W13, W2); tr_load(va, ca.W, ca.N, ca.k0, ca.n0, F.lane); }
        tr_store(vb, cb.WT, cb.ldt, cb.k0, cb.orow0, scr, F.lane);
        if (!more) break;
        it = nit;
    }
    }
}
__device__ __forceinline__ void ph_filter_mlp(Frame& F) {
    float* zs = (float*)F.lds;
    float* ha = zs + 64 * 33;
    float* hb = ha + 64 * 65;
    float* H3 = WSP(float, WS_FILTF);
    constexpr int NITEM = 64 + 4 + 64;
    const int t = F.tid & 63, wv = F.wave;
    for (int item = F.bid; item < NITEM; item += F.G) {
        int e, L, tb, rowbase;
        if (item < 64) { e = 0; L = SEQ; tb = item; rowbase = 0; }
        else if (item < 68) { e = 0; L = CTX; tb = item - 64; rowbase = SEQ; }
        else { e = 1; L = SEQ; tb = item - 68; rowbase = SEQ + CTX; }
        const int tg = tb * 64 + t;
        const float tlin = (float)tg / (float)(L - 1);
        __syncthreads();
        if (wv == 0) { zs[t * 33] = tlin;
#pragma unroll 1
            for (int k = 0; k < 16; ++k) { const float fk = 1e-4f + (float)k * ((15.f - 1e-4f) / 15.f); const float rev = fk * ((float)tg / (float)L);
                zs[t * 33 + 1 + k] = cos_rev(rev); zs[t * 33 + 17 + k] = -sin_rev(rev); } }
        __syncthreads();
        const float* w1 = F.in[I_FW1] + e * 33 * 64; const float* b1 = F.in[I_FB1] + e * 64; const float* w2 = F.in[I_FW2] + e * 64 * 64; const float* b2 = F.in[I_FB2] + e * 64;
        const float* w3 = F.in[I_FW3] + e * 64 * 64; const float* b3 = F.in[I_FB3] + e * 64; const float* fr = F.in[I_FFREQ] + e * 64;
#pragma unroll 1
        for (int jj = 0; jj < 8; ++jj) { const int j = wv * 8 + jj; float a = b1[j];
#pragma unroll 3
            for (int k = 0; k < 33; ++k) a = fmaf(zs[t * 33 + k], w1[k * 64 + j], a);
            ha[t * 65 + j] = sin_rad(fr[j] * a); }
        __syncthreads();
#pragma unroll 1
        for (int jj = 0; jj < 8; ++jj) { const int j = wv * 8 + jj; float a = b2[j];
#pragma unroll 4
            for (int k = 0; k < 64; ++k) a = fmaf(ha[t * 65 + k], w2[k * 64 + j], a);
            hb[t * 65 + j] = sin_rad(fr[j] * a); }
        __syncthreads();
#pragma unroll 1
        for (int jj = 0; jj < 8; ++jj) { const int j = wv * 8 + jj; float a = b3[j];
#pragma unroll 4
            for (int k = 0; k < 64; ++k) a = fmaf(hb[t * 65 + k], w3[k * 64 + j], a);
            ha[t * 65 + j] = sin_rad(fr[j] * a); }
        __syncthreads();
        for (int i = F.tid; i < 64 * 64; i += NTHR) { const int tt = i >> 6, k = i & 63; H3[(size_t)(rowbase + tb * 64 + tt) * 64 + k] = ha[tt * 65 + k]; }
    }
}
template <bool CTXSET>
__device__ __forceinline__ void gr_item(Frame& F, int e, int o, int c0, const float* h3base, float* wl) {
    constexpr int L = CTXSET ? CTX : SEQ, NIDX = 2 * L;
    const float* wo = F.in[I_FWOUT] + (size_t)e * 64 * 2048; const float* hbias = F.in[I_HYBIAS] + (e * 2 + o) * 512 + c0;
    __syncthreads();
    for (int i = F.tid; i < 8 * 2 * 64; i += NTHR) { const int k = i & 63, dir = (i >> 6) & 1, cl = i >> 7; wl[i] = wo[(size_t)k * 2048 + o * 1024 + dir * 512 + c0 + cl]; }
    __syncthreads();
    for (int idx = F.tid; idx < NIDX; idx += NTHR) {
        const int d = L - idx, t = d < 0 ? -d : d; float val[8];
        if (d == L) {
#pragma unroll
            for (int cl = 0; cl < 8; ++cl) val[cl] = 0.f;
        } else {
            const f32x4* hr = (const f32x4*)(h3base + (size_t)t * 64);
            const float tlin = (float)t / (float)(L - 1);
            const int dir = d < 0 ? 1 : 0; const float* wd_ = wl + dir * 64;
#pragma unroll
            for (int cl = 0; cl < 8; ++cl) val[cl] = 0.f;
#pragma unroll 2
            for (int k4 = 0; k4 < 16; ++k4) { const f32x4 h = hr[k4];
#pragma unroll
                for (int cl = 0; cl < 8; ++cl) { const f32x4 w = *(const f32x4*)(wd_ + cl * 128 + 4 * k4); val[cl] += (h[0] * w[0] + h[1] * w[1]) + (h[2] * w[2] + h[3] * w[3]); } }
            if (d == 0) {
#pragma unroll 1
                for (int k4 = 0; k4 < 16; ++k4) { const f32x4 h = hr[k4];
#pragma unroll
                    for (int cl = 0; cl < 8; ++cl) { const f32x4 w = *(const f32x4*)(wl + 64 + cl * 128 + 4 * k4); val[cl] += (h[0] * w[0] + h[1] * w[1]) + (h[2] * w[2] + h[3] * w[3]); } }
#pragma unroll
                for (int cl = 0; cl < 8; ++cl) val[cl] += hbias[cl]; }
#pragma unroll
            for (int cl = 0; cl < 8; ++cl) { const float delta = fabsf(-3.0701134573253944f + (float)(c0 + cl) * ((-15.350567286626972f + 3.0701134573253944f) / 511.f)); val[cl] *= expf(-tlin * delta); }
        }
        if (CTXSET) { float* GRC = WSP(float, WS_GRC);
#pragma unroll
            for (int cl = 0; cl < 8; ++cl) GRC[((size_t)(c0 + cl) * 2 + o) * 512 + idx] = val[cl];
        } else { bf16_t* GR = WSP(bf16_t, WS_GR);
#pragma unroll
            for (int cl = 0; cl < 8; ++cl) GR[(((size_t)e * 512 + c0 + cl) * 2 + o) * 8192 + idx] = f2bf(val[cl]); }
    }
}
__device__ __forceinline__ void ph_build_gr(Frame& F) {
    float* wl = (float*)F.lds;
    const float* H3 = WSP(float, WS_FILTF);
    for (int item = F.bid; item < 256 + 128; item += F.G) {
        if (item < 256) { const int e = item >> 7, o = (item >> 6) & 1, cb = item & 63; gr_item<false>(F, e, o, cb * 8, H3 + (size_t)(e ? SEQ + CTX : 0) * 64, wl); }
        else { const int v = item - 256, o = v >> 6, cb = v & 63; gr_item<true>(F, 0, o, cb * 8, H3 + (size_t)SEQ * 64, wl); }
    }
}
__device__ __forceinline__ void ph_init_norm_a(Frame& F) {
    const float* x = F.in[I_X]; const float* ctx = F.in[I_CTX];
    bf16_t* A = WSP(bf16_t, WS_ABUF); const float* g = F.in[I_NMG]; const float* mods = WSP(float, WS_MODS);
    constexpr int NR = 4;
    for (int r0 = F.gw; r0 < MT; r0 += NR * F.NGW) {
        f32x4 v[NR][4]; bool ok[NR];
#pragma unroll
        for (int q = 0; q < NR; ++q) { const int r = r0 + q * F.NGW; ok[q] = r < MT;
            if (ok[q]) { const int b = r / RPB, j = r - b * RPB;
                const f32x4* src = (const f32x4*)(j < CTX ? ctx + ((size_t)b * CTX + j) * DM : x + ((size_t)b * SEQ + (j - CTX)) * DM);
#pragma unroll
                for (int jj = 0; jj < 4; ++jj) v[q][jj] = src[F.lane + 64 * jj]; } }
#pragma unroll
        for (int q = 0; q < NR; ++q) { if (!ok[q]) continue;
            const int r = r0 + q * F.NGW, b = r / RPB, j = r - b * RPB;
            const float rstd = row_rstd(v[q]); const float* mb = mods + (size_t)(j < CTX ? 8 : b) * 6144;
            norm_mod_store(v[q], rstd, g, mb + 1024, mb, A + (size_t)r * DM, F.lane); } }
}

__device__ __forceinline__ void ph_qk_post(Frame& F, int e) {
    float* cs = (float*)F.lds;
    for (int i = F.tid; i < 64 * 16; i += NTHR) { const int pos = i >> 4, k = i & 15; const float inv = exp2f(-(float)k * (13.287712379549449f / 16.f)); const float rev = (float)pos * inv * 0.15915494309189535f;
        cs[i] = cos_rev(rev); cs[1024 + i] = sin_rev(rev); }
    __syncthreads();
    const bf16_t* P = WSP(bf16_t, WS_P); bf16_t* QB = WSP(bf16_t, WS_QB); bf16_t* KB = WSP(bf16_t, WS_KB);
    const float* qg = F.in[I_QG] + e * 64; const float* kg = F.in[I_KG] + e * 64;
    const int l8 = F.lane & 7;
    for (int r0 = F.gw; r0 < MT; r0 += 2 * F.NGW) {
        u32x4 raw[2][2]; bool ok[2];
#pragma unroll
        for (int q = 0; q < 2; ++q) { const int r = r0 + q * F.NGW; ok[q] = r < MT;
            if (ok[q]) {
#pragma unroll
                for (int which = 0; which < 2; ++which) raw[q][which] = *(const u32x4*)(P + (size_t)(3 + which) * ((size_t)MT * 512) + (size_t)r * 512 + F.lane * 8); } }
#pragma unroll
        for (int q = 0; q < 2; ++q) { if (!ok[q]) continue;
            const int r = r0 + q * F.NGW, b = r / RPB, j = r - b * RPB; const bool lat = j >= CTX; const int tt = j - CTX, pos = (l8 < 4) ? (tt >> 6) : (tt & 63);
#pragma unroll
            for (int which = 0; which < 2; ++which) { const u32x4 rw_ = raw[q][which];
                float x[8]; x[0] = bflo(rw_.x); x[1] = bfhi(rw_.x); x[2] = bflo(rw_.y); x[3] = bfhi(rw_.y); x[4] = bflo(rw_.z); x[5] = bfhi(rw_.z); x[6] = bflo(rw_.w); x[7] = bfhi(rw_.w);
                float ss = 0.f;
#pragma unroll
                for (int i = 0; i < 8; ++i) ss = fmaf(x[i], x[i], ss);
                ss += __shfl_xor(ss, 1); ss += __shfl_xor(ss, 2); ss += __shfl_xor(ss, 4);
                const float rstd = (which ? 1.f : 0.18033688011112042f) / sqrtf(ss * (1.f / 64.f) + NORM_EPS); const float* gg = (which ? kg : qg) + l8 * 8;
#pragma unroll
                for (int i = 0; i < 8; ++i) x[i] = x[i] * rstd * gg[i];
                float y[8];
#pragma unroll
                for (int i = 0; i < 8; ++i) { const float other = __shfl_xor(x[i], 2);
                    if (lat) { const int fi = (l8 & 1) * 8 + i; const float c = cs[pos * 16 + fi], s = cs[1024 + pos * 16 + fi];
                        y[i] = (l8 & 2) ? (other * s + x[i] * c) : (x[i] * c - other * s); }
                    else y[i] = x[i]; }
                u32x4 w; w.x = cvt_pk_bf16(y[0], y[1]); w.y = cvt_pk_bf16(y[2], y[3]); w.z = cvt_pk_bf16(y[4], y[5]); w.w = cvt_pk_bf16(y[6], y[7]);
                st16((which ? KB : QB) + (size_t)r * 512 + F.lane * 8, w); } }
    }
}
__device__ __forceinline__ void ph_shortconv(Frame& F, int e, bool with_ctx) {
    bf16_t* tin = (bf16_t*)F.lds;
    bf16_t* tout = tin + 258 * 72;
    const bf16_t* P = WSP(bf16_t, WS_P); bf16_t* HYT = WSP(bf16_t, WS_HYT);
    const float* cw = F.in[I_CONVW] + (size_t)e * 3 * 1536; const float* cb = F.in[I_CONVB] + (size_t)e * 1536;
    constexpr int NITEM = NB * 3 * 8 * 16, NCTX = NB * 3 * 8;
    bf16_t* HYC = WSP(bf16_t, WS_HYC);
    for (int item = F.bid; item < NITEM + (with_ctx ? NCTX : 0); item += F.G) {
        const bool isc = item >= NITEM; const int it2 = isc ? (item - NITEM) * 16 : item;
        const int tb = it2 & 15, cbk = (it2 >> 4) & 7, part = (it2 >> 7) % 3, b = it2 / (128 * 3);
        const int t0 = tb * 256, c0 = cbk * 64; const bf16_t* Pp = P + (size_t)part * ((size_t)MT * 512);
        const int SL = isc ? CTX : SEQ, rowb = b * RPB + (isc ? 0 : CTX);
        __syncthreads();
        for (int i = F.tid; i < 258 * 8; i += NTHR) { const int rr = i >> 3, ch = i & 7, t = t0 - 1 + rr; u32x4 v = {0u, 0u, 0u, 0u};
            if (t >= 0 && t < SL) v = *(const u32x4*)(Pp + ((size_t)rowb + t) * 512 + c0 + ch * 8);
            *(u32x4*)(tin + rr * 72 + ch * 8) = v; }
        __syncthreads();
        { const int cl = F.tid & 63, tg = F.tid >> 6, chn = part * 512 + c0 + cl; const float w0 = cw[chn], w1 = cw[1536 + chn], w2 = cw[3072 + chn], bs = cb[chn];
#pragma unroll
          for (int k = 0; k < 4; ++k) { float y[8];
#pragma unroll
            for (int i = 0; i < 8; ++i) { const int rr = (tg * 4 + k) * 8 + i; y[i] = w0 * bf2f(tin[rr * 72 + cl]) + w1 * bf2f(tin[(rr + 1) * 72 + cl]) + w2 * bf2f(tin[(rr + 2) * 72 + cl]) + bs; }
            u32x4 w; w.x = cvt_pk_bf16(y[0], y[1]); w.y = cvt_pk_bf16(y[2], y[3]); w.z = cvt_pk_bf16(y[4], y[5]); w.w = cvt_pk_bf16(y[6], y[7]);
            *(u32x4*)(tout + cl * 264 + (tg * 4 + k) * 8) = w; } }
        __syncthreads();
        for (int i = F.tid; i < 64 * 32; i += NTHR) { const int cl = i >> 5, ch = i & 31; const u32x4 v = *(const u32x4*)(tout + cl * 264 + ch * 8);
          if (isc) st16(HYC + (size_t)part * ((size_t)NB * 512 * CTX) + ((size_t)b * 512 + c0 + cl) * CTX + ch * 8, v);
          else st16(HYT + (size_t)part * ((size_t)NB * 512 * SEQ) + ((size_t)b * 512 + c0 + cl) * SEQ + t0 + ch * 8, v); }
    }
}

constexpr int HY_UST = 4240;
constexpr int HY_GST = 16704;
constexpr int HY_U_BYTES = NB * HY_UST * 2;
__device__ __forceinline__ void hy_load_g(Frame& F, const bf16_t* gr) {
    char* G0 = F.lds + HY_U_BYTES;
    unsigned zz = 0u; asm volatile("" : "+v"(zz));
    for (int q = F.tid; q < 1044; q += NTHR) { u32x4 v = {zz, zz, zz, zz}; if (q >= 8 && q < 1032) v = *(const u32x4*)(gr + (q - 8) * 8); *(u32x4*)(G0 + q * 16) = v; }
    __syncthreads();
    for (int q = F.tid; q < 1040; q += NTHR) { const u32x4 a = *(const u32x4*)(G0 + q * 16), c = *(const u32x4*)(G0 + q * 16 + 16);
        u32x4 o1, o2, o3;
        o1.x = __builtin_amdgcn_alignbit(a.y, a.x, 16); o1.y = __builtin_amdgcn_alignbit(a.z, a.y, 16); o1.z = __builtin_amdgcn_alignbit(a.w, a.z, 16); o1.w = __builtin_amdgcn_alignbit(c.x, a.w, 16);
        o2.x = a.y; o2.y = a.z; o2.z = a.w; o2.w = c.x;
        o3.x = __builtin_amdgcn_alignbit(a.z, a.y, 16); o3.y = __builtin_amdgcn_alignbit(a.w, a.z, 16); o3.z = __builtin_amdgcn_alignbit(c.x, a.w, 16); o3.w = __builtin_amdgcn_alignbit(c.y, c.x, 16);
        *(u32x4*)(G0 + 1 * HY_GST + q * 16) = o1; *(u32x4*)(G0 + 2 * HY_GST + q * 16) = o2; *(u32x4*)(G0 + 3 * HY_GST + q * 16) = o3; }
}
__device__ __forceinline__ void hy_conv(Frame& F, f32x4 (&acc)[16]) {
    const int lane = F.lane, j = lane & 15, q = lane >> 4, n = lane & 15, b = n & 7, sg = n >> 3, tau = F.wave * 512;
    const int r = (4 - (j & 3)) & 3;
    const char* ab0 = F.lds + HY_U_BYTES + r * HY_GST + (4096 - j + 8 * q - r + 64) * 2 - 2 * (tau + 32);
    const char* ub = F.lds + b * (HY_UST * 2) + (16 * sg + 8 * q) * 2;
    bf16x8 W[16];
#define HY_LDA(dst, p) do { const u32x2 lo_ = *(const u32x2*)(p); const u32x2 hi_ = *(const u32x2*)((p) + 8); u32x4 t_ = {lo_.x, lo_.y, hi_.x, hi_.y}; dst = __builtin_bit_cast(bf16x8, t_); } while (0)
#pragma unroll
    for (int i = 0; i < 16; ++i) { acc[i] = (f32x4){0.f, 0.f, 0.f, 0.f}; HY_LDA(W[i], ab0 - 64 * i); }
    { const bf16x8 B = *(const bf16x8*)ub;
#pragma unroll
      for (int i = 0; i < 16; ++i) acc[i] = __builtin_amdgcn_mfma_f32_16x16x32_bf16(W[i], B, acc[i], 0, 0, 0); }
    for (int kb = 0; kb < 8; ++kb) {
#pragma unroll
        for (int kk = 1; kk <= 16; ++kk) { const int k = kb * 16 + kk;
            HY_LDA(W[(16 - kk) & 15], ab0 + 64 * k);
            const bf16x8 B = *(const bf16x8*)(ub + 64 * k);
#pragma unroll
            for (int i = 0; i < 16; ++i) acc[i] = __builtin_amdgcn_mfma_f32_16x16x32_bf16(W[(i - kk + 32) & 15], B, acc[i], 0, 0, 0); }
    }
#undef HY_LDA
}
__device__ __forceinline__ void ph_hyena(Frame& F, int e) {
    bf16_t* HYT = WSP(bf16_t, WS_HYT); const bf16_t* GR = WSP(bf16_t, WS_GR);
    const float* cw = F.in[I_CONVW] + (size_t)e * 3 * 1536; const float* cb = F.in[I_CONVB] + (size_t)e * 1536;
    const int lane = F.lane, q = lane >> 4, n = lane & 15, b = n & 7, sg = n >> 3, tau = F.wave * 512;
    for (int c = F.bid; c < 512; c += F.G) {
        __syncthreads();
        { const bf16_t* src = HYT + 2 * ((size_t)NB * 512 * SEQ) + ((size_t)F.wave * 512 + c) * SEQ; char* urow = F.lds + F.wave * (HY_UST * 2);
          const float w0 = cw[1024 + c], w1 = cw[1536 + 1024 + c], w2 = cw[3072 + 1024 + c], bs = cb[1024 + c];
#pragma unroll
          for (int i = 0; i < 8; ++i) { const int ch = lane + 64 * i; const u32x4 raw = *(const u32x4*)(src + ch * 8);
              float x[10]; x[0] = ch > 0 ? bf2f(src[ch * 8 - 1]) : 0.f; x[9] = ch < 511 ? bf2f(src[ch * 8 + 8]) : 0.f;
              x[1] = bflo(raw.x); x[2] = bfhi(raw.x); x[3] = bflo(raw.y); x[4] = bfhi(raw.y); x[5] = bflo(raw.z); x[6] = bfhi(raw.z); x[7] = bflo(raw.w); x[8] = bfhi(raw.w);
              float y[8];
#pragma unroll
              for (int k = 0; k < 8; ++k) y[k] = w0 * x[k] + w1 * x[k + 1] + w2 * x[k + 2] + bs;
              u32x4 w; w.x = cvt_pk_bf16(y[0], y[1]); w.y = cvt_pk_bf16(y[2], y[3]); w.z = cvt_pk_bf16(y[4], y[5]); w.w = cvt_pk_bf16(y[6], y[7]);
              *(u32x4*)(urow + 64 + ch * 16) = w; }
          unsigned zz = 0u; asm volatile("" : "+v"(zz)); const u32x4 zv = {zz, zz, zz, zz};
          if (lane < 4) *(u32x4*)(urow + lane * 16) = zv;
          if (lane >= 8 && lane < 22) *(u32x4*)(urow + 64 + 8192 + (lane - 8) * 16) = zv; }
        hy_load_g(F, GR + (((size_t)e * 512 + c) * 2 + 0) * 8192);
        __syncthreads();
        f32x4 acc[16];
        hy_conv(F, acc);
        __syncthreads();
#define HY_GATE(GP, W0, W1, W2, BS, T, G4) do { const u32x2 gw_ = *(const u32x2*)((GP) + (T)); const float xm_ = (T) > 0 ? bf2f((GP)[(T) - 1]) : 0.f, xp_ = (T) + 4 < SEQ ? bf2f((GP)[(T) + 4]) : 0.f; \
            const float x0_ = bflo(gw_.x), x1_ = bfhi(gw_.x), x2_ = bflo(gw_.y), x3_ = bfhi(gw_.y); \
            G4[0] = W0 * xm_ + W1 * x0_ + W2 * x1_ + BS; G4[1] = W0 * x0_ + W1 * x1_ + W2 * x2_ + BS; G4[2] = W0 * x1_ + W1 * x2_ + W2 * x3_ + BS; G4[3] = W0 * x2_ + W1 * x3_ + W2 * xp_ + BS; } while (0)
        { const bf16_t* gate = HYT + 0 * ((size_t)NB * 512 * SEQ) + ((size_t)b * 512 + c) * SEQ; char* urow = F.lds + b * (HY_UST * 2);
          const float w0 = cw[c], w1 = cw[1536 + c], w2 = cw[3072 + c], bs = cb[c];
#pragma unroll
          for (int i = 0; i < 16; ++i) { const int t = tau + 32 * i + 16 * sg + 4 * q; float g4[4]; HY_GATE(gate, w0, w1, w2, bs, t, g4);
              u32x2 w; w.x = cvt_pk_bf16(acc[i][0] * g4[0], acc[i][1] * g4[1]); w.y = cvt_pk_bf16(acc[i][2] * g4[2], acc[i][3] * g4[3]);
              *(u32x2*)(urow + (32 + t) * 2) = w; } }
        hy_load_g(F, GR + (((size_t)e * 512 + c) * 2 + 1) * 8192);
        __syncthreads();
        hy_conv(F, acc);
        { const bf16_t* gate = HYT + 1 * ((size_t)NB * 512 * SEQ) + ((size_t)b * 512 + c) * SEQ; bf16_t* dst = HYT + 3 * ((size_t)NB * 512 * SEQ) + ((size_t)b * 512 + c) * SEQ;
          const float w0 = cw[512 + c], w1 = cw[1536 + 512 + c], w2 = cw[3072 + 512 + c], bs = cb[512 + c];
#pragma unroll
          for (int i = 0; i < 16; ++i) { const int t = tau + 32 * i + 16 * sg + 4 * q; float g4[4]; HY_GATE(gate, w0, w1, w2, bs, t, g4);
              u32x2 w; w.x = cvt_pk_bf16(acc[i][0] * g4[0], acc[i][1] * g4[1]); w.y = cvt_pk_bf16(acc[i][2] * g4[2], acc[i][3] * g4[3]);
              *(u32x2*)(dst + t) = w; } }
#undef HY_GATE
    }
}
__device__ __forceinline__ void ph_hyena_ctx(Frame& F, int e) {
    float* us = (float*)(F.lds) + F.wave * 768;
    float* gs = us + 256;
    const bf16_t* HYC = WSP(bf16_t, WS_HYC); const float* GRC = WSP(float, WS_GRC); bf16_t* A = WSP(bf16_t, WS_ABUF);
    const float* cw = F.in[I_CONVW] + (size_t)e * 3 * 1536; const float* cb = F.in[I_CONVB] + (size_t)e * 1536;
    for (int item = F.gw; item < NB * 512; item += F.NGW) { const int b = item >> 9, c = item & 511;
        float xg[2][4], v[4];
#pragma unroll
        for (int part = 0; part < 3; ++part) { const u32x2 w = *(const u32x2*)(HYC + (size_t)part * ((size_t)NB * 512 * CTX) + ((size_t)b * 512 + c) * CTX + F.lane * 4);
            const int chn = part * 512 + c; const float w0 = cw[chn], w1 = cw[1536 + chn], w2 = cw[3072 + chn], bs = cb[chn];
            const float x0 = bflo(w.x), x1 = bfhi(w.x), x2 = bflo(w.y), x3 = bfhi(w.y);
            float xm = __shfl_up(x3, 1), xp = __shfl_down(x0, 1); if (F.lane == 0) xm = 0.f; if (F.lane == 63) xp = 0.f;
            const float y0 = w0 * xm + w1 * x0 + w2 * x1 + bs, y1 = w0 * x0 + w1 * x1 + w2 * x2 + bs, y2 = w0 * x1 + w1 * x2 + w2 * x3 + bs, y3 = w0 * x2 + w1 * x3 + w2 * xp + bs;
            if (part == 0) { xg[0][0] = y0; xg[0][1] = y1; xg[0][2] = y2; xg[0][3] = y3; } else if (part == 1) { xg[1][0] = y0; xg[1][1] = y1; xg[1][2] = y2; xg[1][3] = y3; } else { v[0] = y0; v[1] = y1; v[2] = y2; v[3] = y3; } }
#pragma unroll
        for (int o = 0; o < 2; ++o) {
            LDS_WAIT(); __builtin_amdgcn_wave_barrier();
#pragma unroll
            for (int i = 0; i < 4; ++i) us[F.lane * 4 + i] = v[i];
#pragma unroll
            for (int i = 0; i < 8; ++i) gs[F.lane + 64 * i] = GRC[((size_t)c * 2 + o) * 512 + F.lane + 64 * i];
            LDS_WAIT(); __builtin_amdgcn_wave_barrier();
            float y[4] = {0.f, 0.f, 0.f, 0.f};
            for (int s = 0; s < CTX; ++s) { const float uv = us[s];
#pragma unroll
                for (int i = 0; i < 4; ++i) y[i] = fmaf(gs[256 - (F.lane * 4 + i) + s], uv, y[i]); }
#pragma unroll
            for (int i = 0; i < 4; ++i) v[i] = xg[o][i] * y[i];
        }
#pragma unroll
        for (int i = 0; i < 4; ++i) A[((size_t)b * RPB + F.lane * 4 + i) * DM + c] = f2bf(v[i]);
    }
}
__device__ __forceinline__ void ph_attn(Frame& F, int e, int l, bool with_ctx, int i0, int i1) {
    const bf16_t* QB = WSP(bf16_t, WS_QB); const bf16_t* KB = WSP(bf16_t, WS_KB); const bf16_t* VB = WSP(bf16_t, WS_P) + 5 * ((size_t)MT * 512); bf16_t* A = WSP(bf16_t, WS_ABUF);
    const float* lv = F.in[I_LAMBDA] + e * 4 * 64; const float lam_init = 0.8f - 0.6f * expf(-0.3f * (float)l);
    const float* sg = F.in[I_SUBLN] + e * 128;
    int ln = F.lane; asm volatile("" : "+v"(ln));
    float mq = fabsf(F.in[I_QG][e * 64 + ln]), mk = fabsf(F.in[I_KG][e * 64 + ln]);
#pragma unroll
    for (int o = 1; o < 64; o <<= 1) { mq = fmaxf(mq, __shfl_xor(mq, o)); mk = fmaxf(mk, __shfl_xor(mk, o)); }
    const float lam = expf(wave_sum(lv[ln] * lv[64 + ln])) - expf(wave_sum(lv[128 + ln] * lv[192 + ln])) + lam_init;
    const float negbound = -(8.f * 1.4426950408889634f) * mq * mk * 1.0001f;
    const float lam_s = __builtin_bit_cast(float, __builtin_amdgcn_readfirstlane(__builtin_bit_cast(int, lam))), nb_s = __builtin_bit_cast(float, __builtin_amdgcn_readfirstlane(__builtin_bit_cast(int, negbound))),
                osc_s = __builtin_bit_cast(float, __builtin_amdgcn_readfirstlane(__builtin_bit_cast(int, 1.f - lam_init)));
    const int nun = NB * 4 * 32 + (with_ctx ? NB * 4 * 2 : 0);
    const int vcu = (F.G % 8 == 0) ? (F.bid % 8) * (F.G / 8) + F.bid / 8 : F.bid;
    for (int i = i0; i < i1; ++i) { const int u = vcu + i * F.G; if (u >= nun) break;
        int b, h, row0, seq;
        if (u < NB * 4 * 32) { const int bh = u >> 5, qb = u & 31; b = bh >> 2; h = bh & 3; row0 = b * RPB + CTX + qb * 128; seq = RPB; }
        else { const int v = u - NB * 4 * 32, bh = v >> 1, qb = v & 1; b = bh >> 2; h = bh & 3; row0 = b * RPB + qb * 128; seq = CTX; }
        const size_t kbase = (size_t)b * RPB * 512 + h * 128, qbase = (size_t)row0 * 512 + h * 128;
        att::attn_unit(QB + qbase, KB + kbase, VB + kbase, A + (size_t)row0 * DM + 512 + h * 128, lam_s, osc_s, sg, nb_s, seq, F.lds);
    }
}
__device__ __forceinline__ void ph_mix(Frame& F, int e, int l, bool with_ctx) {
    bf16_t* A = WSP(bf16_t, WS_ABUF);
    { bf16_t* tl = (bf16_t*)F.lds;
      const bf16_t* HY = WSP(bf16_t, WS_HYT) + 3 * ((size_t)NB * 512 * SEQ);
      const int cl = F.tid >> 3, ch = F.tid & 7; constexpr int NIT = NB * 8 * 64;
      auto src = [&](int item) { const int tb = item & 63, cbk = (item >> 6) & 7, b = item >> 9; return (const u32x4*)(HY + ((size_t)b * 512 + cbk * 64 + cl) * SEQ + tb * 64 + ch * 8); };
      u32x4 cur = {0u, 0u, 0u, 0u}; if (F.bid < NIT) cur = *src(F.bid);
      for (int item = F.bid; item < NIT; item += F.G) { const int tb = item & 63, cbk = (item >> 6) & 7, b = item >> 9, t0 = tb * 64, c0 = cbk * 64;
          u32x4 nxt = {0u, 0u, 0u, 0u}; if (item + F.G < NIT) nxt = *src(item + F.G);
          __syncthreads();
          *(u32x4*)(tl + cl * 72 + ch * 8) = cur;
          __syncthreads();
          { const int tloc = F.tid >> 3, cc = F.tid & 7; unsigned short v[8];
#pragma unroll
            for (int i = 0; i < 8; ++i) v[i] = tl[(cc * 8 + i) * 72 + tloc];
            u32x4 w; w.x = v[0] | ((unsigned)v[1] << 16); w.y = v[2] | ((unsigned)v[3] << 16); w.z = v[4] | ((unsigned)v[5] << 16); w.w = v[6] | ((unsigned)v[7] << 16);
            st16(A + ((size_t)b * RPB + CTX + t0 + tloc) * DM + c0 + cc * 8, w); }
          cur = nxt; } }
}

__device__ __forceinline__ void ph_router(Frame& F, int l, bool with_ctx) {
    float* rw = (float*)F.lds;
    const float* R = F.in[I_ROUTER] + (size_t)l * DM * NE;
    __syncthreads();
    for (int i = F.tid; i < DM * NE; i += NTHR) { const int col = i >> 4, ex = i & 15; rw[ex * DM + col] = R[i]; }
    __syncthreads();
    const h16_t* H = WSP(h16_t, WS_H); float* AFF = WSP(float, WS_AFF); bf16_t* FIN = WSP(bf16_t, WS_XS);
    const float* g = F.in[I_NFG] + l * DM; const float* mods = WSP(float, WS_MODS) + (size_t)l * 9 * 6144;
    const int lane = F.lane, ex = ((lane >> 5) & 1) * 8 + ((lane >> 4) & 1) * 4 + ((lane >> 3) & 1) * 2 + ((lane >> 2) & 1);
    for (int r0 = F.gw; r0 < MT; r0 += 2 * F.NGW) {
        f32x4 v[2][4]; bool ok[2]; int rb[2], rj[2];
#pragma unroll
        for (int q = 0; q < 2; ++q) { const int r = r0 + q * F.NGW; rb[q] = r / RPB; rj[q] = r - rb[q] * RPB; ok[q] = r < MT && !(rj[q] < CTX && !with_ctx);
#pragma unroll
            for (int jj = 0; jj < 4; ++jj) v[q][jj] = (f32x4){0.f, 0.f, 0.f, 0.f};
            if (ok[q]) { const u32x2* src = (const u32x2*)(H + (size_t)r * DM);
#pragma unroll
                for (int jj = 0; jj < 4; ++jj) v[q][jj] = h4_f32(src[lane + 64 * jj]); } }
#pragma unroll
        for (int q = 0; q < 2; ++q) { if (!ok[q]) continue;
            const int r = r0 + q * F.NGW, b = rb[q], j = rj[q];
            const float rstd = row_rstd(v[q]); const float* mb = mods + (size_t)(j < CTX ? 8 : b) * 6144;
#pragma unroll
            for (int jj = 0; jj < 4; ++jj) { const int col = 4 * lane + 256 * jj; const f32x4 gg = *(const f32x4*)(g + col), s1 = *(const f32x4*)(mb + 4 * 1024 + col), s0 = *(const f32x4*)(mb + 3 * 1024 + col);
                v[q][jj] = v[q][jj] * rstd * gg * (s1 + 1.f) + s0; }
            { bf16_t* fo = FIN + (size_t)r * DM;
#pragma unroll
              for (int jj = 0; jj < 4; ++jj) { u32x2 w; w.x = cvt_pk_bf16(v[q][jj][0], v[q][jj][1]); w.y = cvt_pk_bf16(v[q][jj][2], v[q][jj][3]); st8(fo + 4 * lane + 256 * jj, w); } } }
        float a[2][16]; int lo4 = 4 * lane; asm volatile("" : "+v"(lo4)); const float* rwl = rw + lo4;
#pragma unroll
        for (int e2 = 0; e2 < 16; ++e2) { float t0 = 0.f, t1 = 0.f;
#pragma unroll
            for (int jj = 0; jj < 4; ++jj) { const f32x4 w = *(const f32x4*)(rwl + e2 * DM + 256 * jj);
                t0 += (v[0][jj][0] * w[0] + v[0][jj][1] * w[1]) + (v[0][jj][2] * w[2] + v[0][jj][3] * w[3]);
                t1 += (v[1][jj][0] * w[0] + v[1][jj][1] * w[1]) + (v[1][jj][2] * w[2] + v[1][jj][3] * w[3]); }
            if ((e2 & 3) == 3) asm volatile("" : "+v"(t0), "+v"(t1), "+v"(a[0][e2 - 1]), "+v"(a[1][e2 - 1]), "+v"(a[0][e2 - 2]), "+v"(a[1][e2 - 2]), "+v"(a[0][e2 - 3]), "+v"(a[1][e2 - 3]) :: "memory");
            a[0][e2] = t0; a[1][e2] = t1; }
#pragma unroll
        for (int q = 0; q < 2; ++q) { if (!ok[q]) continue;
            const int b = rb[q], j = rj[q];
#pragma unroll
            for (int i = 0; i < 8; ++i) { const bool hb = lane & 32; const float keep = hb ? a[q][8 + i] : a[q][i], send = hb ? a[q][i] : a[q][8 + i]; a[q][i] = keep + __shfl_xor(send, 32); }
#pragma unroll
            for (int i = 0; i < 4; ++i) { const bool hb = lane & 16; const float keep = hb ? a[q][4 + i] : a[q][i], send = hb ? a[q][i] : a[q][4 + i]; a[q][i] = keep + __shfl_xor(send, 16); }
#pragma unroll
            for (int i = 0; i < 2; ++i) { const bool hb = lane & 8; const float keep = hb ? a[q][2 + i] : a[q][i], send = hb ? a[q][i] : a[q][2 + i]; a[q][i] = keep + __shfl_xor(send, 8); }
            { const bool hb = lane & 4; const float keep = hb ? a[q][1] : a[q][0], send = hb ? a[q][0] : a[q][1]; a[q][0] = keep + __shfl_xor(send, 4); }
            float lgt = a[q][0]; lgt += __shfl_xor(lgt, 2); lgt += __shfl_xor(lgt, 1);
            float mx = lgt;
#pragma unroll
            for (int o = 4; o < 64; o <<= 1) mx = fmaxf(mx, __shfl_xor(mx, o));
            const float ev = expf(lgt - mx); float se = ev;
#pragma unroll
            for (int o = 4; o < 64; o <<= 1) se += __shfl_xor(se, o);
            if ((lane & 3) == 0) AFF[((size_t)b * NE + ex) * RPB + j] = ev / se; }
    }
}
__device__ __forceinline__ void ph_topk(Frame& F, bool with_ctx) {
    unsigned* cnt = (unsigned*)F.lds;
    const float* AFF = WSP(float, WS_AFF); int* TOK = WSP(int, WS_TOKROW); float* PG = WSP(float, WS_PGATE); int* SLOT = WSP(int, WS_SLOT);
    const int nprob = NB * NE * (with_ctx ? 2 : 1);
    for (int pr = F.bid; pr < nprob; pr += F.G) {
        const int kind = pr / (NB * NE), be = pr % (NB * NE), b = be / NE, e = be % NE;
        const int n = kind ? CTX : SEQ, cap = kind ? CAPC : CAPL, j0 = kind ? 0 : CTX;
        const float* av = AFF + ((size_t)b * NE + e) * RPB + j0;
        unsigned key[8];
#pragma unroll
        for (int k = 0; k < 8; ++k) { const int idx = F.tid * 8 + k; key[k] = idx < n ? __float_as_uint(av[idx]) : 0u; }
        const bool act = F.tid * 8 < n;
        unsigned T = 0u; int it = 0;
#pragma unroll 1
        for (int bit = 30; bit >= 0; --bit, ++it) { const unsigned cand = T | (1u << bit); unsigned c = 0u;
#pragma unroll
            for (int k = 0; k < 8; ++k) c += (act && key[k] >= cand) ? 1u : 0u;
#pragma unroll
            for (int o = 1; o < 64; o <<= 1) c += __shfl_xor(c, o);
            unsigned* slot = cnt + (it & 1) * 8; if (F.lane == 0) slot[F.wave] = c;
            __syncthreads();
            unsigned tot = 0u;
#pragma unroll
            for (int w = 0; w < 8; ++w) tot += slot[w];
            if (tot >= (unsigned)cap) T = cand; }
        __syncthreads();
        unsigned gt = 0u, eq = 0u;
#pragma unroll
        for (int k = 0; k < 8; ++k) { gt += (act && key[k] > T) ? 1u : 0u; eq += (act && key[k] == T) ? 1u : 0u; }
        unsigned eqx = eq, gts = gt;
#pragma unroll
        for (int o = 1; o < 64; o <<= 1) { const unsigned t = __shfl_up(eqx, o); if (F.lane >= o) eqx += t; gts += __shfl_xor(gts, o); }
        if (F.lane == 63) cnt[16 + F.wave] = eqx; if (F.lane == 0) cnt[24 + F.wave] = gts;
        __syncthreads();
        unsigned eqbase = 0u, gttot = 0u;
#pragma unroll
        for (int w = 0; w < 8; ++w) { if (w < F.wave) eqbase += cnt[16 + w]; gttot += cnt[24 + w]; }
        const unsigned need = (unsigned)cap - gttot;
        unsigned eqrank = eqbase + eqx - eq;
        unsigned sel = 0u, selmask = 0u;
#pragma unroll
        for (int k = 0; k < 8; ++k) { bool s = act && key[k] > T; if (act && key[k] == T) { s = eqrank < need; ++eqrank; } if (s) { ++sel; selmask |= 1u << k; } }
        unsigned sx = sel;
#pragma unroll
        for (int o = 1; o < 64; o <<= 1) { const unsigned t = __shfl_up(sx, o); if (F.lane >= o) sx += t; }
        __syncthreads();
        if (F.lane == 63) cnt[16 + F.wave] = sx;
        __syncthreads();
        unsigned sbase = 0u;
#pragma unroll
        for (int w = 0; w < 8; ++w) if (w < F.wave) sbase += cnt[16 + w];
        unsigned pos = sbase + sx - sel;
        const int rrbase = kind ? NB * CAPL + b * CAPC : b * CAPL;
#pragma unroll
        for (int k = 0; k < 8; ++k) { const int idx = F.tid * 8 + k; if (idx < n) { int sl = -1;
                if (selmask & (1u << k)) { sl = rrbase + (int)pos; TOK[(size_t)e * ME + sl] = b * RPB + j0 + idx; PG[(size_t)e * ME + sl] = __uint_as_float(key[k]); ++pos; }
                SLOT[((size_t)b * RPB + j0 + idx) * NE + e] = sl; } }
        __syncthreads();
    }
}
__device__ __forceinline__ void ph_combine(Frame& F, int l, bool with_ctx, bool dry = false) {
    const bool split = with_ctx && moe_split(F.G); const bf16_t* YP2 = WSP(bf16_t, WS_OBUF);
    h16_t* H = WSP(h16_t, WS_H); const int* SLOT = WSP(int, WS_SLOT); const bf16_t* YP = WSP(bf16_t, WS_YP); bf16_t* A = WSP(bf16_t, WS_ABUF);
    const float* mods = WSP(float, WS_MODS) + (size_t)l * 9 * 6144; const float* modsn = mods + 9 * 6144; const float* gn = F.in[I_NMG] + (l + 1) * DM; float* out = ((float*)F.in[31]);
    const int lane = F.lane;
    constexpr int NR = 4;
    for (int r0 = F.gw; r0 < MT; r0 += NR * F.NGW) {
        int rb[NR], rj[NR], myslot[NR]; bool ok[NR]; u32x2 hv[NR][4];
#pragma unroll
        for (int q = 0; q < NR; ++q) { const int r = r0 + q * F.NGW; rb[q] = r / RPB; rj[q] = r - rb[q] * RPB; ok[q] = r < MT && !(rj[q] < CTX && !with_ctx); myslot[q] = -1;
            if (ok[q]) { myslot[q] = SLOT[((size_t)rb[q] * RPB + rj[q]) * NE + (lane & 15)]; const u32x2* hp = (const u32x2*)(H + (size_t)r * DM);
#pragma unroll
                for (int jj = 0; jj < 4; ++jj) hv[q][jj] = hp[lane + 64 * jj]; } }
#pragma unroll
        for (int q = 0; q < NR; ++q) { if (!ok[q]) continue;
            const int r = r0 + q * F.NGW, b = rb[q], j = rj[q]; const bool isctx = j < CTX;
            f32x4 s[4];
#pragma unroll
            for (int jj = 0; jj < 4; ++jj) s[jj] = (f32x4){0.f, 0.f, 0.f, 0.f};
            unsigned long long msk = __ballot(myslot[q] >= 0) & 0xffffull; if (dry) msk = 0ull;
            while (msk) {
                const int e0 = __builtin_ctzll(msk); msk &= msk - 1; const int sl0 = __builtin_amdgcn_readlane(myslot[q], e0);
                const u32x2* yp0 = (const u32x2*)(YP + ((size_t)e0 * ME + sl0) * DM);
                if (msk) { const int e1 = __builtin_ctzll(msk); msk &= msk - 1; const int sl1 = __builtin_amdgcn_readlane(myslot[q], e1);
                    const u32x2* yp1 = (const u32x2*)(YP + ((size_t)e1 * ME + sl1) * DM); u32x2 w0[4], w1[4];
#pragma unroll
                    for (int jj = 0; jj < 4; ++jj) { w0[jj] = __builtin_nontemporal_load(yp0 + lane + 64 * jj); w1[jj] = __builtin_nontemporal_load(yp1 + lane + 64 * jj); }
#pragma unroll
                    for (int jj = 0; jj < 4; ++jj) { s[jj][0] += bflo(w0[jj].x); s[jj][1] += bfhi(w0[jj].x); s[jj][2] += bflo(w0[jj].y); s[jj][3] += bfhi(w0[jj].y);
                        s[jj][0] += bflo(w1[jj].x); s[jj][1] += bfhi(w1[jj].x); s[jj][2] += bflo(w1[jj].y); s[jj][3] += bfhi(w1[jj].y); }
                } else {
#pragma unroll
                    for (int jj = 0; jj < 4; ++jj) { const u32x2 w = __builtin_nontemporal_load(yp0 + lane + 64 * jj); s[jj][0] += bflo(w.x); s[jj][1] += bfhi(w.x); s[jj][2] += bflo(w.y); s[jj][3] += bfhi(w.y); } }
            }
            if (split && isctx) {
                unsigned long long m2 = __ballot(myslot[q] >= 0) & 0xffffull; if (dry) m2 = 0ull;
                while (m2) { const int e0 = __builtin_ctzll(m2); m2 &= m2 - 1; const int sl0 = __builtin_amdgcn_readlane(myslot[q], e0) - NB * CAPL;
                    const u32x2* yp0 = (const u32x2*)(YP2 + ((size_t)e0 * 256 + sl0) * DM);
#pragma unroll
                    for (int jj = 0; jj < 4; ++jj) { const u32x2 w = __builtin_nontemporal_load(yp0 + lane + 64 * jj); s[jj][0] += bflo(w.x); s[jj][1] += bfhi(w.x); s[jj][2] += bflo(w.y); s[jj][3] += bfhi(w.y); } } }
            const float* mb = mods + (size_t)(isctx ? 8 : b) * 6144; f32x4 v[4];
#pragma unroll
            for (int jj = 0; jj < 4; ++jj) { const int col = 4 * lane + 256 * jj; v[jj] = h4_f32(hv[q][jj]) + *(const f32x4*)(mb + 5 * 1024 + col) * s[jj]; }
            if (l == DEPTH - 1) { f32x4* op = (f32x4*)(out + ((size_t)b * SEQ + (j - CTX)) * DM);
#pragma unroll
                for (int jj = 0; jj < 4; ++jj) st16f(op + lane + 64 * jj, v[jj]);
            } else { u32x2* hp = (u32x2*)(H + (size_t)r * DM);
#pragma unroll
                for (int jj = 0; jj < 4; ++jj) st8(hp + lane + 64 * jj, f32_h4(v[jj]));
                const float rstd = row_rstd(v); const float* mn = modsn + (size_t)(isctx ? 8 : b) * 6144;
                norm_mod_store(v, rstd, gn, mn + 1024, mn, A + (size_t)r * DM, lane); }
        }
    }
}
__device__ __forceinline__ void ph_pool_in(Frame& F, bool with_ctx) {
    const bf16_t* A = WSP(bf16_t, WS_ABUF); bf16_t* PB = WSP(bf16_t, WS_P); bf16_t* tile = (bf16_t*)F.lds;
    const int nlat = NB * 64 * 4, ntot = nlat + (with_ctx ? NB * 4 * 4 : 0);
    auto decode = [&](int item, int& b, int& tb, int& gi, int& L, int& base) {
        if (item < nlat) { b = item >> 8; tb = (item >> 2) & 63; gi = item & 3; L = SEQ; base = b * RPB + CTX; }
        else { const int v = item - nlat; b = v >> 4; tb = (v >> 2) & 3; gi = v & 3; L = CTX; base = b * RPB; } };
    auto fetch = [&](int item, u32x4 (&pre)[5]) { int b, tb, gi, L, base; decode(item, b, tb, gi, L, base); const int hw = 1 << gi, t0 = tb * 64, nrows = 64 + 2 * hw;
#pragma unroll
        for (int k = 0; k < 5; ++k) { const int i = F.tid + k * NTHR, rr = i >> 5, ch = i & 31, t = t0 - hw + rr; u32x4 v = {0u, 0u, 0u, 0u};
            if (i < nrows * 32 && t >= 0 && t < L) v = *(const u32x4*)(A + (size_t)(base + t) * DM + gi * 256 + ch * 8);
            pre[k] = v; } };
    u32x4 cur[5], nxt[5];
    if (F.bid < ntot) fetch(F.bid, cur);
    for (int item = F.bid; item < ntot; item += F.G) {
        int b, tb, gi, L, base; decode(item, b, tb, gi, L, base);
        const int hw = 1 << gi, t0 = tb * 64, nrows = 64 + 2 * hw;
        if (item + F.G < ntot) fetch(item + F.G, nxt);
        __syncthreads();
#pragma unroll
        for (int k = 0; k < 5; ++k) { const int i = F.tid + k * NTHR, rr = i >> 5, ch = i & 31; if (i < nrows * 32) *(u32x4*)(tile + rr * 264 + ch * 8) = cur[k]; }
        __syncthreads();
        const int tr = F.tid >> 3, t = t0 + tr, lo = max(t - hw, 0), hi = min(t + hw, L); const float inv = 1.f / (float)(hi - lo);
#pragma unroll
        for (int k = 0; k < 4; ++k) { const int ch = (F.tid & 7) + 8 * k; float s[8];
#pragma unroll
            for (int q = 0; q < 8; ++q) s[q] = 0.f;
            for (int rr = tr; rr < tr + 2 * hw; ++rr) { const u32x4 w = *(const u32x4*)(tile + rr * 264 + ch * 8);
                s[0] += bflo(w.x); s[1] += bfhi(w.x); s[2] += bflo(w.y); s[3] += bfhi(w.y); s[4] += bflo(w.z); s[5] += bfhi(w.z); s[6] += bflo(w.w); s[7] += bfhi(w.w); }
            const u32x4 me = *(const u32x4*)(tile + (tr + hw) * 264 + ch * 8);
            u32x4 o; o.x = cvt_pk_bf16(s[0] * inv - bflo(me.x), s[1] * inv - bfhi(me.x)); o.y = cvt_pk_bf16(s[2] * inv - bflo(me.y), s[3] * inv - bfhi(me.y));
            o.z = cvt_pk_bf16(s[4] * inv - bflo(me.z), s[5] * inv - bfhi(me.z)); o.w = cvt_pk_bf16(s[6] * inv - bflo(me.w), s[7] * inv - bfhi(me.w));
            st16(PB + (size_t)(base + t) * DM + gi * 256 + ch * 8, o); }
#pragma unroll
        for (int k = 0; k < 5; ++k) cur[k] = nxt[k];
    }
}

__device__ __forceinline__ void ph_pool_gemm(Frame& F, int e, int l, bool with_ctx) {
    const bf16_t* A = WSP(bf16_t, WS_ABUF); h16_t* H = WSP(h16_t, WS_H); const bf16_t* WT = WSP(bf16_t, WS_POOLT) + (size_t)e * 1024 * 256;
    const float* gate_l = WSP(float, WS_MODS) + (size_t)l * 9 * 6144 + 2 * 1024; const float* scale = F.in[I_POOLS] + e * DM;
    bf16_t* tile = (bf16_t*)F.lds;
    bf16_t* pbt = tile + 80 * 264;
    float* ct = (float*)(F.lds + (80 + 64) * 264 * 2);
    const int nlat = NB * 64 * 4, ntot = nlat + (with_ctx ? NB * 4 * 4 : 0);
    auto decode = [&](int item, int& b, int& tb, int& gi, int& L, int& base) {
        if (item < nlat) { b = item >> 8; tb = (item >> 2) & 63; gi = item & 3; L = SEQ; base = b * RPB + CTX; }
        else { const int v = item - nlat; b = v >> 4; tb = (v >> 2) & 3; gi = v & 3; L = CTX; base = b * RPB; } };
    auto fetch = [&](int item, u32x4 (&pre)[5]) { int b, tb, gi, L, base; decode(item, b, tb, gi, L, base); const int hw = 1 << gi, t0 = tb * 64, nrows = 64 + 2 * hw;
#pragma unroll
        for (int k = 0; k < 5; ++k) { const int i = F.tid + k * NTHR, rr = i >> 5, ch = i & 31, t = t0 - hw + rr; u32x4 v = {0u, 0u, 0u, 0u};
            if (i < nrows * 32 && t >= 0 && t < L) v = *(const u32x4*)(A + (size_t)(base + t) * DM + gi * 256 + ch * 8);
            pre[k] = v; } };
    const int lane = F.lane, wv = F.wave, fr = lane & 15, fg = lane >> 4;
#define LBAR() asm volatile("s_waitcnt lgkmcnt(0)\n\ts_barrier" ::: "memory")
    u32x4 cur[5], nxt[5];
    if (F.bid < ntot) fetch(F.bid, cur);
    for (int item = F.bid; item < ntot; item += F.G) {
        int b, tb, gi, L, base; decode(item, b, tb, gi, L, base);
        const int hw = 1 << gi, t0 = tb * 64, nrows = 64 + 2 * hw;
        if (item + F.G < ntot) fetch(item + F.G, nxt);
        bf16x8 bw[8][2];
#pragma unroll
        for (int ks = 0; ks < 8; ++ks)
#pragma unroll
            for (int nb = 0; nb < 2; ++nb) bw[ks][nb] = *(const bf16x8*)(WT + (size_t)(gi * 256 + 32 * wv + 16 * nb + fr) * 256 + 32 * ks + 8 * fg);
        const int erow = F.tid >> 5, ech = F.tid & 31; h16_t* hp = H + (size_t)(base + t0 + erow) * DM + gi * 256 + ech * 8;
        u32x4 hraw[4];
#pragma unroll
        for (int m = 0; m < 4; ++m) hraw[m] = *(const u32x4*)(hp + (size_t)(16 * m) * DM);
        const float* gp = gate_l + (size_t)(L == CTX ? 8 : b) * 6144 + gi * 256 + ech * 8; const float* sp = scale + gi * 256 + ech * 8;
        const f32x4 gs0 = *(const f32x4*)gp * *(const f32x4*)sp, gs1 = *(const f32x4*)(gp + 4) * *(const f32x4*)(sp + 4);
        LBAR();
#pragma unroll
        for (int k = 0; k < 5; ++k) { const int i = F.tid + k * NTHR, rr = i >> 5, ch = i & 31; if (i < nrows * 32) *(u32x4*)(tile + rr * 264 + ch * 8) = cur[k]; }
        LBAR();
        { const int tr = F.tid >> 3, t = t0 + tr, lo = max(t - hw, 0), hi = min(t + hw, L); const float inv = 1.f / (float)(hi - lo);
#pragma unroll
          for (int k = 0; k < 4; ++k) { const int ch = (F.tid & 7) + 8 * k; float s[8];
#pragma unroll
            for (int q = 0; q < 8; ++q) s[q] = 0.f;
            for (int rr = tr; rr < tr + 2 * hw; ++rr) { const u32x4 w = *(const u32x4*)(tile + rr * 264 + ch * 8);
                s[0] += bflo(w.x); s[1] += bfhi(w.x); s[2] += bflo(w.y); s[3] += bfhi(w.y); s[4] += bflo(w.z); s[5] += bfhi(w.z); s[6] += bflo(w.w); s[7] += bfhi(w.w); }
            const u32x4 me = *(const u32x4*)(tile + (tr + hw) * 264 + ch * 8);
            u32x4 o; o.x = cvt_pk_bf16(s[0] * inv - bflo(me.x), s[1] * inv - bfhi(me.x)); o.y = cvt_pk_bf16(s[2] * inv - bflo(me.y), s[3] * inv - bfhi(me.y));
            o.z = cvt_pk_bf16(s[4] * inv - bflo(me.z), s[5] * inv - bfhi(me.z)); o.w = cvt_pk_bf16(s[6] * inv - bflo(me.w), s[7] * inv - bfhi(me.w));
            *(u32x4*)(pbt + tr * 264 + ch * 8) = o; } }
        LBAR();
        f32x4 acc[4][2];
#pragma unroll
        for (int m = 0; m < 4; ++m)
#pragma unroll
            for (int nb = 0; nb < 2; ++nb) acc[m][nb] = (f32x4){0.f, 0.f, 0.f, 0.f};
#pragma unroll
        for (int ks = 0; ks < 8; ++ks) { bf16x8 af[4];
#pragma unroll
            for (int m = 0; m < 4; ++m) af[m] = *(const bf16x8*)(pbt + (16 * m + fr) * 264 + 32 * ks + 8 * fg);
#pragma unroll
            for (int m = 0; m < 4; ++m)
#pragma unroll
                for (int nb = 0; nb < 2; ++nb) acc[m][nb] = __builtin_amdgcn_mfma_f32_16x16x32_bf16(af[m], bw[ks][nb], acc[m][nb], 0, 0, 0); }
#pragma unroll
        for (int m = 0; m < 4; ++m)
#pragma unroll
            for (int nb = 0; nb < 2; ++nb)
#pragma unroll
                for (int i = 0; i < 4; ++i) ct[(16 * m + 4 * fg + i) * 260 + 32 * wv + 16 * nb + fr] = acc[m][nb][i];
        LBAR();
#pragma unroll
        for (int m = 0; m < 4; ++m) { const float* cp = ct + (erow + 16 * m) * 260 + ech * 8; const f32x4 c0 = *(const f32x4*)cp, c1 = *(const f32x4*)(cp + 4);
            const f32x4 h0 = h4_f32((u32x2){hraw[m].x, hraw[m].y}), h1 = h4_f32((u32x2){hraw[m].z, hraw[m].w});
            const u32x2 o0 = f32_h4(h0 + gs0 * c0), o1 = f32_h4(h1 + gs1 * c1);
            *(u32x4*)(hp + (size_t)(16 * m) * DM) = (u32x4){o0.x, o0.y, o1.x, o1.y}; }
#pragma unroll
        for (int k = 0; k < 5; ++k) cur[k] = nxt[k];
    }
#undef LBAR
}

#ifndef ENMASK
#define ENMASK 0xFFFFFFFFu
#endif
#ifndef RPTMASK
#define RPTMASK 0u
#endif
#define EN(k, ...) do { if constexpr ((ENMASK >> (k)) & 1u) { if constexpr ((RPTMASK >> (k)) & 1u) { _Pragma("unroll 1") for (int rep_ = 0; rep_ < 2; ++rep_) { __VA_ARGS__ __syncthreads(); } } else { __VA_ARGS__ } } } while (0);
constexpr int NPHASES = 2 + 2 * 9 + 2 * 6;
__device__ __forceinline__ int opaque_tid() { int t = threadIdx.x; asm volatile("" : "+v"(t)); return t; }
__device__ __forceinline__ void mkframe(Frame& F, char* lds) {
    F.lds = lds; F.tid = opaque_tid(); F.lane = F.tid & 63; F.wave = __builtin_amdgcn_readfirstlane(F.tid >> 6);
    F.G = gridDim.x; F.bid = blockIdx.x; F.gw = F.bid * NWAVES + F.wave; F.NGW = F.G * NWAVES;
    int z = 0; asm volatile("" : "+s"(z));
    F.in = (katab_t)((__attribute__((address_space(4))) const unsigned char*)__builtin_amdgcn_kernarg_segment_ptr() + z); F.ws = (unsigned char*)F.in[32];
}
__global__ void __launch_bounds__(NTHR, 2) mk_fwd(Params prm) {
    extern __shared__ __attribute__((aligned(16))) unsigned char lds_raw[];
    volatile LAS unsigned* MISC = (volatile LAS unsigned*)((LAS unsigned char*)lds_raw + MISC_OFF);
    if (threadIdx.x < 64) MISC[threadIdx.x] = 0u;
    __syncthreads();
    const int lo = prm.ph_lo, hi = prm.ph_hi;
    XcdBarrier bar; bar.bar = (unsigned*)(prm.ws + WS_CTL); bar.x = 0; bar.st = nullptr;
    if (hi - lo > 1) bar = xcd_barrier_post((unsigned*)(prm.ws + WS_CTL), MISC + 8);
    int ph = 0;
    LAS unsigned char* ldsg = (LAS unsigned char*)lds_raw;
#define PH_BEGIN if (ph >= lo && ph < hi) { Frame F; mkframe(F, (char*)lds_raw);
#define PH_END   if (ph + 1 < hi) xcd_barrier(bar); } ++ph;

    PH_BEGIN EN(0, ph_mods(F); __syncthreads(); ph_cvt_small(F); __syncthreads();) EN(1, ph_filter_mlp(F);) PH_END
    PH_BEGIN EN(2, ph_build_gr(F); ph_init_norm_a(F);) PH_END
    for (int l = 0; l < DEPTH; ++l) {
        const int e = l >> 1; const bool ctx_full = l < 2;
        if ((l & 1) == 0) {
            PH_BEGIN {
                { float* cst = (float*)(F.lds + 131072);
                  for (int i = F.tid; i < 64 * 16; i += NTHR) { const int pos = i >> 4, k = i & 15; const float inv = exp2f(-(float)k * (13.287712379549449f / 16.f)); const float rev = (float)pos * inv * 0.15915494309189535f;
                      cst[i] = cos_rev(rev); cst[1024 + i] = sin_rev(rev); }
                  __syncthreads(); }
                pg8::Gemm g{WSP(bf16_t, WS_ABUF), WSP(bf16_t, WS_WINT) + (size_t)e * INW * DM, DM, DM, DM};
                pg8::SchedWin S; S.init(MT / 256, F.G, F.bid, (long)((WS_WINT + (size_t)e * INW * DM * 2)) - (long)WS_ABUF);
                pg8::EpiWin E{WSP(bf16_t, WS_P), WSP(bf16_t, WS_HYT), WSP(bf16_t, WS_HYC), WSP(bf16_t, WS_QB), WSP(bf16_t, WS_KB), F.in[I_QG] + e * 64, F.in[I_KG] + e * 64, (const PG8_LAS float*)(ldsg + 131072)};
                EN(3, (pg8::gemm_phase<pg8::EpiWin, pg8::SchedWin, true, true>(ldsg, g, S, E));) } PH_END
            PH_BEGIN {
                const int grp = (F.bid >> 3) & 3;
                if (grp == 0) { EN(12, ph_cvt_experts(F, l); ph_cvt_experts(F, l + 1); __syncthreads();) }
                EN(5, ph_hyena(F, e);) EN(6, if (l == 0) { __syncthreads(); ph_hyena_ctx(F, e); }) __syncthreads();
                if (grp == 1) { EN(12, ph_cvt_experts(F, l); ph_cvt_experts(F, l + 1); __syncthreads();) }
                EN(7, ph_attn(F, e, l, l == 0, 0, 2);)
                if (grp == 2) { EN(12, __syncthreads(); ph_cvt_experts(F, l); ph_cvt_experts(F, l + 1); __syncthreads();) }
                EN(7, ph_attn(F, e, l, l == 0, 2, 64);)
                if (grp == 3) { EN(12, __syncthreads(); ph_cvt_experts(F, l); ph_cvt_experts(F, l + 1);) } } PH_END
            PH_BEGIN EN(8, ph_mix(F, e, l, l == 0);) PH_END
            PH_BEGIN {
                pg8::Gemm g{WSP(bf16_t, WS_ABUF), WSP(bf16_t, WS_WOUTT) + (size_t)e * DM * DM, DM, DM, DM};
                pg8::SchedDense S; S.init(ctx_full ? MT / 256 : NB * 16, DM / 256, F.G, F.bid, ctx_full ? 0 : 1, DM, DM, 0);
                pg8::EpiResid E{WSP(h16_t, WS_H), WSP(float, WS_MODS) + (size_t)l * 9 * 6144, nullptr, 1.f, l == 0 ? F.in[I_X] : nullptr, F.in[I_CTX]};
                EN(9, (pg8::gemm_phase<pg8::EpiResid, pg8::SchedDense, true, true>(ldsg, g, S, E));)
#if ((RPTMASK >> 20) & 1u)
                { pg8::EpiResid E2{WSP(h16_t, WS_H), WSP(float, WS_MODS) + (size_t)l * 9 * 6144, nullptr, 0.f, nullptr, nullptr}; __syncthreads(); pg8::gemm_phase<pg8::EpiResid, pg8::SchedDense, true, true>(ldsg, g, S, E2); }
#endif
            } PH_END
        } else {
            PH_BEGIN EN(10, ph_pool_gemm(F, e, l, ctx_full);) PH_END
        }
        PH_BEGIN EN(13, ph_router(F, l, ctx_full);) PH_END
        PH_BEGIN EN(14, ph_topk(F, ctx_full);) PH_END
        PH_BEGIN {
            pg8::Gemm g{WSP(bf16_t, WS_XS), (bf16_t*)(F.ws + WS_W13T + (size_t)(l & 1) * W13T_BYTES), DM, DM, DM};
            pg8::SchedMoe S; S.init(ctx_full ? 17 : 16, 16, F.G, F.bid, DM, DM);
            PG8_LAS unsigned short* gtab = (PG8_LAS unsigned short*)(ldsg + 131072);
            { pg8::Unit u; const int* TOK = WSP(int, WS_TOKROW);
              for (int ui = F.tid >> 8; S.next(ui, u); ui += 2) gtab[ui * 256 + (F.tid & 255)] = (unsigned short)TOK[(size_t)u.pm * 256 + (F.tid & 255)];
              __syncthreads(); }
            pg8::EpiSwiglu E{WSP(bf16_t, WS_ACT)};
            EN(16, (pg8::gemm_phase<pg8::EpiSwiglu, pg8::SchedMoe, true, true, true>(ldsg, g, S, E, gtab));)
#if ((RPTMASK >> 23) & 1u)
            { pg8::EpiNull E2{0}; __syncthreads(); pg8::gemm_phase<pg8::EpiNull, pg8::SchedMoe, true, true, true>(ldsg, g, S, E2, gtab); }
#endif
            } PH_END
        PH_BEGIN {
            const bool split = ctx_full && moe_split(F.G);
#pragma unroll 1
            for (int pass = 0; pass < (split ? 2 : 1); ++pass) {
                pg8::Gemm g{WSP(bf16_t, WS_ACT), (bf16_t*)(F.ws + WS_W2T + (size_t)(l & 1) * W2T_BYTES), pass ? FF / 2 : FF, FF, FF};
                pg8::SchedMoe S; S.init((ctx_full && !split) ? 17 : 16, 4, F.G, F.bid, FF, FF); S.cx = pass;
                pg8::EpiDown E{WSP(bf16_t, WS_YP), WSP(float, WS_PGATE), WSP(bf16_t, WS_OBUF)};
                if (pass) __syncthreads();
                EN(17, (pg8::gemm_phase<pg8::EpiDown, pg8::SchedMoe, true, true>(ldsg, g, S, E));) } } PH_END
        PH_BEGIN EN(18, ph_combine(F, l, ctx_full);)
#if ((RPTMASK >> 22) & 1u)
            if (l < DEPTH - 1) { __syncthreads(); ph_combine(F, l, ctx_full, true); }
#endif
        PH_END
    }
#if ((RPTMASK >> 19) & 1u)
    if (hi - lo > 1) { for (int i = 0; i < 40; ++i) xcd_barrier(bar); }
#endif
#undef PH_BEGIN
#undef PH_END
}

extern "C" void kernel_launch(void* const* d_in, const int* in_sizes, int n_in, void* d_out, int out_size, void* d_ws, size_t ws_size, hipStream_t stream) {
    static int grid = 0;
    if (grid == 0) {
        if (n_in != 31 || out_size != NB * SEQ * DM || ws_size < WS_END) { fprintf(stderr, "kernel_launch: unexpected shapes (n_in %d out %d ws %zu need %zu)\n", n_in, out_size, ws_size, (size_t)WS_END); grid = -1; return; }
        int dev = 0, cus = 0, per_cu = 0;
        if (hipGetDevice(&dev) != hipSuccess || hipDeviceGetAttribute(&cus, hipDeviceAttributeMultiprocessorCount, dev) != hipSuccess) { grid = -1; return; }
        if (hipFuncSetAttribute((const void*)mk_fwd, hipFuncAttributeMaxDynamicSharedMemorySize, LDS_BYTES) != hipSuccess) { fprintf(stderr, "kernel_launch: hipFuncSetAttribute failed\n"); grid = -1; return; }
        if (hipOccupancyMaxActiveBlocksPerMultiprocessor(&per_cu, (const void*)mk_fwd, NTHR, LDS_BYTES) != hipSuccess || per_cu < 1) fprintf(stderr, "kernel_launch: occupancy query reports %d\n", per_cu);
        (void)hipGetLastError();
        grid = cus;
    }
    if (grid < 0) return;
    (void)hipMemsetAsync((char*)d_ws + WS_CTL, 0, CTL_BYTES, stream);
    Params p{};
    for (int i = 0; i < 31; ++i) p.in[i] = (const float*)d_in[i];
    p.out = (float*)d_out; p.ws = (unsigned char*)d_ws;
#if MK_ONE_LAUNCH
    p.ph_lo = 0; p.ph_hi = NPHASES;
    hipLaunchKernelGGL(mk_fwd, dim3(grid), dim3(NTHR), LDS_BYTES, stream, p);
#else
    for (int k = 0; k < NPHASES; ++k) { p.ph_lo = k; p.ph_hi = k + 1; hipLaunchKernelGGL(mk_fwd, dim3(grid), dim3(NTHR), LDS_BYTES, stream, p); }
#endif
    const hipError_t le = hipPeekAtLastError();
    if (le != hipSuccess) fprintf(stderr, "kernel_launch: launch failed: %s\n", hipGetErrorName(le));
}
```

```cpp
#include <hip/hip_runtime.h>
#include <cstdio>
#include <cstdint>

#ifndef MK_ONE_LAUNCH
#define MK_ONE_LAUNCH 1
#endif

#define GAS __attribute__((address_space(1)))
#define LAS __attribute__((address_space(3)))
typedef unsigned short bf16_t;
typedef short bf16x8 __attribute__((ext_vector_type(8)));
typedef short s16x4 __attribute__((ext_vector_type(4)));
typedef float f32x4 __attribute__((ext_vector_type(4)));
typedef float f32x2 __attribute__((ext_vector_type(2)));
typedef float f32x8 __attribute__((ext_vector_type(8)));
typedef float f32x16 __attribute__((ext_vector_type(16)));
typedef unsigned u32x4 __attribute__((ext_vector_type(4)));
typedef unsigned u32x2 __attribute__((ext_vector_type(2)));

constexpr int NB = 8, SEQ = 4096, CTX = 256, RPB = SEQ + CTX, MT = NB * RPB, DM = 1024, DEPTH = 4;
constexpr int TPB = RPB / 256;
constexpr int HYW = 512, INW = 3072, NE = 16, FF = 2048, CAPL = 512, CAPC = 32, ME = NB * CAPL + NB * CAPC;
constexpr int NWAVES = 8, NTHR = 512;
constexpr float NORM_EPS = 1e-6f;

constexpr size_t al256(size_t x) { return (x + 255) / 256 * 256; }
constexpr size_t WS_CTL = 0, CTL_BYTES = 1u << 20;
constexpr size_t WS_MODS = WS_CTL + CTL_BYTES;
constexpr size_t WS_WINT = al256(WS_MODS + (size_t)4 * 9 * 6144 * 4);
constexpr size_t WS_WOUTT = al256(WS_WINT + (size_t)2 * 3072 * 1024 * 2);
constexpr size_t WS_POOLT = al256(WS_WOUTT + (size_t)2 * 1024 * 1024 * 2);
constexpr size_t WS_FILTF = al256(WS_POOLT + (size_t)2 * 1024 * 256 * 2);
constexpr size_t WS_FILTC = al256(WS_FILTF + (size_t)2 * 2 * 2 * 512 * 4096 * 4);
constexpr size_t WS_GR = al256(WS_FILTC + (size_t)2 * 2 * 512 * 256 * 4);
constexpr size_t WS_GRC = al256(WS_GR + (size_t)2 * 512 * 2 * 8192 * 2);
constexpr size_t WS_H = al256(WS_GRC + (size_t)512 * 2 * 512 * 4);
constexpr size_t WS_ABUF = al256(WS_H + (size_t)MT * DM * 4);
constexpr size_t WS_P = al256(WS_ABUF + (size_t)MT * DM * 2);
constexpr size_t P_PART = (size_t)MT * 512 * 2;
constexpr size_t WS_HYT = al256(WS_P + 6 * P_PART);
constexpr size_t HYT_PART = (size_t)NB * 512 * SEQ * 2;
constexpr size_t WS_HYC = al256(WS_HYT + 4 * HYT_PART);
constexpr size_t WS_QB = al256(WS_HYC + (size_t)3 * NB * 512 * CTX * 2);
constexpr size_t WS_KB = al256(WS_QB + P_PART);
constexpr size_t WS_OBUF = al256(WS_KB + P_PART);
constexpr size_t WS_AFF = al256(WS_OBUF + (size_t)2 * MT * 512 * 4);
constexpr size_t WS_RSTD = al256(WS_AFF + (size_t)NB * NE * RPB * 4);
constexpr size_t WS_TOKROW = al256(WS_RSTD + (size_t)MT * 4);
constexpr size_t WS_PGATE = al256(WS_TOKROW + (size_t)NE * ME * 4);
constexpr size_t WS_SLOT = al256(WS_PGATE + (size_t)NE * ME * 4);
constexpr size_t WS_XS = al256(WS_SLOT + (size_t)NB * NE * RPB * 4);
constexpr size_t WS_ACT = al256(WS_XS + (size_t)NE * ME * DM * 2);
constexpr size_t WS_YP = al256(WS_ACT + (size_t)NE * ME * FF * 2);
constexpr size_t WS_W13T = al256(WS_YP + (size_t)NE * ME * DM * 2);
constexpr size_t W13T_BYTES = (size_t)NE * 4096 * 1024 * 2, W2T_BYTES = (size_t)NE * 1024 * 2048 * 2;
constexpr size_t WS_W2T = al256(WS_W13T + 2 * W13T_BYTES);
constexpr size_t WS_END = al256(WS_W2T + 2 * W2T_BYTES);

constexpr int LDS_BYTES = 147456;
constexpr int MISC_OFF = LDS_BYTES - 256;

#define LDS_WAIT() asm volatile("s_waitcnt lgkmcnt(0)" ::: "memory")
#define VM_WAIT() asm volatile("s_waitcnt vmcnt(0)" ::: "memory")
typedef __bf16 bf16x2_t __attribute__((ext_vector_type(2)));
__device__ __forceinline__ unsigned cvt_pk_bf16(float lo, float hi) { f32x2 v = {lo, hi}; bf16x2_t b = __builtin_convertvector(v, bf16x2_t); return __builtin_bit_cast(unsigned, b); }
#ifndef NT_STORES
#define NT_STORES 0
#endif
__device__ __forceinline__ void st16(void* p, u32x4 v) {
#if NT_STORES
    __builtin_nontemporal_store(v, (u32x4*)p);
#else
    *(u32x4*)p = v;
#endif
}
__device__ __forceinline__ void st8(void* p, u32x2 v) {
#if NT_STORES
    __builtin_nontemporal_store(v, (u32x2*)p);
#else
    *(u32x2*)p = v;
#endif
}
__device__ __forceinline__ void st16f(void* p, f32x4 v) { st16(p, __builtin_bit_cast(u32x4, v)); }
__device__ __forceinline__ unsigned short f2bf(float f) { return (unsigned short)(cvt_pk_bf16(f, 0.f) & 0xffffu); }
__device__ __forceinline__ float bf2f(unsigned short h) { return __builtin_bit_cast(float, (unsigned)h << 16); }
__device__ __forceinline__ float bflo(unsigned w) { return __builtin_bit_cast(float, w << 16); }
typedef _Float16 h16_t; typedef _Float16 h16x4 __attribute__((ext_vector_type(4)));
__device__ __forceinline__ f32x4 h4_f32(u32x2 w) { return __builtin_convertvector(__builtin_bit_cast(h16x4, w), f32x4); }
__device__ __forceinline__ u32x2 f32_h4(f32x4 v) { return __builtin_bit_cast(u32x2, __builtin_convertvector(v, h16x4)); }
__device__ __forceinline__ float bfhi(unsigned w) { return __builtin_bit_cast(float, w & 0xffff0000u); }
__device__ __forceinline__ float wave_sum(float v) {
#pragma unroll
    for (int o = 1; o < 64; o <<= 1) v += __shfl_xor(v, o);
    return v;
}
__device__ __forceinline__ float sin_rad(float x) { float r = x * 0.15915494309189535f; r = r - rintf(r); return __builtin_amdgcn_sinf(r); }
__device__ __forceinline__ float sin_rev(float r) { r = r - rintf(r); return __builtin_amdgcn_sinf(r); }
__device__ __forceinline__ float cos_rev(float r) { r = r - rintf(r); return __builtin_amdgcn_cosf(r); }
__device__ __forceinline__ float siluf(float x) { return x / (1.f + __expf(-x)); }

#define XB_TMO      128
#define XB_XCNT(j)  (256  + 64 * (j))
#define XB_XSUB(j)  (1280 + 64 * (j))
#define XB_XGEN(j)  (2304 + 64 * (j))
#define XB_TOP      3328
#define XB_TOPGEN   3392
#define XCD_BAR_WORDS 3456
#define XB_SPIN_CAP (1u << 20)

__device__ __forceinline__ unsigned xb_ld(unsigned* p)              { return __hip_atomic_load(p, __ATOMIC_RELAXED, __HIP_MEMORY_SCOPE_AGENT); }
__device__ __forceinline__ unsigned xb_add(unsigned* p, unsigned v) { return __hip_atomic_fetch_add(p, v, __ATOMIC_RELAXED, __HIP_MEMORY_SCOPE_AGENT); }
__device__ __forceinline__ unsigned xb_xcc_id() { return (unsigned)__builtin_amdgcn_s_getreg((3 << 11) | 20) & 0xFu; }
#define XB_SPIN(cond, bar) do { unsigned _sp = 0; while (cond) { __builtin_amdgcn_s_sleep(1); \
    if ((++_sp & 255u) == 0u) { if (xb_ld(&(bar)[XB_TMO])) break; if (_sp > XB_SPIN_CAP) { atomicAdd(&(bar)[XB_TMO], 1u); break; } } } } while (0)

struct XcdBarrier {
    unsigned* bar; unsigned x;
    volatile LAS unsigned* st;
};

__device__ __forceinline__ XcdBarrier xcd_barrier_post(unsigned* bar, volatile LAS unsigned* st) {
    XcdBarrier b; b.bar = bar; b.x = xb_xcc_id(); b.st = st;
    if (threadIdx.x == 0) (void)xb_add(&bar[XB_XCNT(b.x)], 1u);
    return b;
}
__device__ __forceinline__ void xcd_barrier_complete(unsigned* bar, unsigned x, unsigned& nloc, unsigned& nx) {
    const unsigned G = gridDim.x * gridDim.y * gridDim.z;
    unsigned sum, cnt, mine, sp = 0u;
    for (;;) {
        sum = 0u; cnt = 0u; mine = 0u;
#pragma unroll
        for (unsigned j = 0; j < 16; ++j) { const unsigned c = xb_ld(&bar[XB_XCNT(j)]); sum += c; cnt += (c > 0u) ? 1u : 0u; mine = (j == x) ? c : mine; }
        if (sum == G) break;
        __builtin_amdgcn_s_sleep(1);
        if ((++sp & 255u) == 0u) { if (xb_ld(&bar[XB_TMO])) break; if (sp > XB_SPIN_CAP) { atomicAdd(&bar[XB_TMO], 1u); break; } }
    }
    nloc = mine > 0u ? mine : 1u; nx = cnt > 0u ? cnt : 1u;
}

__device__ __forceinline__ void xcd_barrier(const XcdBarrier& b) {
    asm volatile("s_waitcnt vmcnt(0)" ::: "memory");
    __syncthreads();
    if (threadIdx.x == 0) {
        unsigned* bar = b.bar;
        __builtin_amdgcn_s_waitcnt(0);
        unsigned nloc = b.st[0], nx = b.st[1];
        if (nloc == 0u) { xcd_barrier_complete(bar, b.x, nloc, nx); b.st[0] = nloc; b.st[1] = nx; }
        const unsigned old = xb_add(&bar[XB_XSUB(b.x)], 1u);
        const unsigned gen = old / nloc;
        if (old + 1u == (gen + 1u) * nloc) {
            __builtin_amdgcn_fence(__ATOMIC_RELEASE, "agent");
            asm volatile("s_waitcnt vmcnt(0)" ::: "memory");
            const unsigned og = xb_add(&bar[XB_TOP], 1u);
            const unsigned tg = og / nx;
            if (og + 1u == (tg + 1u) * nx) xb_add(&bar[XB_TOPGEN], 1u);
            else XB_SPIN(xb_ld(&bar[XB_TOPGEN]) == tg, bar);
            __builtin_amdgcn_fence(__ATOMIC_ACQUIRE, "agent");
            xb_add(&bar[XB_XGEN(b.x)], 1u);
            asm volatile("s_waitcnt vmcnt(0)" ::: "memory");
        } else {
            XB_SPIN(xb_ld(&bar[XB_XGEN(b.x)]) == gen, bar);
            __builtin_amdgcn_fence(__ATOMIC_ACQUIRE, "agent");
            asm volatile("s_waitcnt vmcnt(0)" ::: "memory");
        }
    }
    __syncthreads();
}


namespace pg8 {
#define PG8_LAS __attribute__((address_space(3)))
constexpr int BM = 256, BK = 64, HALF = 128, HTB = HALF * BK * 2, STAGE_BYTES = 8 * HTB, NXCD = 8, WGM = 8;
__host__ __device__ __forceinline__ int lds_byte(int r, int c) { const int st = (r >> 4) * 2 + (c >> 5), rr = r & 15, cc = c & 31, ob = rr * 64 + cc * 2; return st * 1024 + (ob ^ (((ob >> 9) & 1) << 5)); }
__host__ __device__ __forceinline__ void stage_rc(int b, int& R, int& C) { const int st = b / 1024, sb = b % 1024, swz = sb ^ (((sb >> 9) & 1) << 5); R = (st >> 1) * 16 + swz / 64; C = (st & 1) * 32 + (swz % 64) / 2; }
__host__ __device__ __forceinline__ int perm32(int rho) { const int n = rho >> 4, i = rho & 15; return 8 * (i >> 2) + 4 * n + (i & 3); }
struct Unit { int pm, pn, e, x; };
struct Gemm { const bf16_t* A; const bf16_t* Bt; int K, lda, ldb; };
template <class Epi, class Sched, bool ALIGN_EPI = false, bool SP2 = false, bool GATHER = false>
__device__ __forceinline__ void gemm_phase(PG8_LAS unsigned char* lds, const Gemm g, const Sched& S, const Epi& E, const PG8_LAS unsigned short* gtab = nullptr) {
    int tid = threadIdx.x; asm volatile("" : "+v"(tid)); const int wid = __builtin_amdgcn_readfirstlane(tid >> 6), lane = tid & 63, wr = wid >> 2, wc = wid & 3, fr = lane & 15, fq = lane >> 4;
    const int K = g.K, nt = K / BK;
    unsigned voffA[2], voffB[2], Cb[2]; int Rr[2];
#pragma unroll
    for (int i = 0; i < 2; ++i) { int R, C; stage_rc(tid * 16 + i * 8192, R, C); const int Rb = Epi::PERM ? ((R & ~31) + perm32(R & 31)) : R;
        voffA[i] = (unsigned)(R * g.lda + C) * 2u; voffB[i] = (unsigned)(Rb * g.ldb + C) * 2u; Rr[i] = R; Cb[i] = (unsigned)C * 2u; }
    const size_t kstep = (size_t)(BK * 2);
    const size_t hstepA = (size_t)HALF * g.lda * 2, hstepB = (size_t)HALF * g.ldb * 2;
    const unsigned ldsw = (unsigned)wid * 1024u;
    const int aoff = lds_byte(wr * 64 + fr, fq * 8), boff = lds_byte(wc * 32 + fr, fq * 8);
#define PG8_SA(b, h) (((b) * 2 + (h)) * HTB)
#define PG8_SB(b, h) ((4 + (b) * 2 + (h)) * HTB)
#define PG8_STAGE(bufoff, gbase, voff) do { _Pragma("unroll") for (int _i = 0; _i < 2; ++_i) \
        __builtin_amdgcn_global_load_lds((const unsigned*)((const char*)(gbase) + (voff)[_i]), (PG8_LAS unsigned*)(lds + (bufoff) + ldsw + _i * 8192), 16, 0, 0); } while (0)
#define PG8_LDA(dst, b, h) do { _Pragma("unroll") for (int m = 0; m < 4; ++m) _Pragma("unroll") for (int k = 0; k < 2; ++k) dst[m][k] = *(const PG8_LAS bf16x8*)(lds + PG8_SA(b, h) + aoff + m * 2048 + k * 1024); } while (0)
#define PG8_LDB(dst, b, h) do { _Pragma("unroll") for (int n = 0; n < 2; ++n) _Pragma("unroll") for (int k = 0; k < 2; ++k) dst[n][k] = *(const PG8_LAS bf16x8*)(lds + PG8_SB(b, h) + boff + n * 2048 + k * 1024); } while (0)
#define PG8_MMA(ai, bj, At, Bt) do { __builtin_amdgcn_s_setprio(1); _Pragma("unroll") for (int m = 0; m < 4; ++m) _Pragma("unroll") for (int n = 0; n < 2; ++n) _Pragma("unroll") for (int k = 0; k < 2; ++k) \
        acc[ai][bj][m][n] = __builtin_amdgcn_mfma_f32_16x16x32_bf16(Bt[n][k], At[m][k], acc[ai][bj][m][n], 0, 0, 0); __builtin_amdgcn_s_setprio(0); } while (0)
#define PG8_WAIT_V(n) asm volatile("s_waitcnt vmcnt(" #n ")" ::: "memory")
#define PG8_WAIT_L(n) asm volatile("s_waitcnt lgkmcnt(" #n ")" ::: "memory")
#define PG8_BAR __builtin_amdgcn_s_barrier()
#define PG8_SCHED __builtin_amdgcn_sched_barrier(0)
    Unit cur, nxt; int ui = 0;
    if (!S.next(0, cur)) return;
    f32x4 acc[2][2][4][2];
#pragma unroll
    for (int a = 0; a < 2; ++a)
#pragma unroll
        for (int b = 0; b < 2; ++b)
#pragma unroll
            for (int m = 0; m < 4; ++m)
#pragma unroll
                for (int n = 0; n < 2; ++n) acc[a][b][m][n] = (f32x4){0.f, 0.f, 0.f, 0.f};
    bf16x8 At[4][2], B0[2][2], B1[2][2];
    u32x4 pend[8]; bf16_t* pbase = nullptr; bool have_pend = false;
    const char* cA = GATHER ? (const char*)g.A : (const char*)g.A + S.aoff(cur); const char* cB = (const char*)g.Bt + S.boff(cur);
    unsigned oc0[2], oc1[2], on0[2], on1[2];
#pragma unroll
    for (int i = 0; i < 2; ++i) {
        if constexpr (GATHER) { oc0[i] = (unsigned)gtab[Rr[i]] * (unsigned)(g.lda * 2) + Cb[i]; oc1[i] = (unsigned)gtab[HALF + Rr[i]] * (unsigned)(g.lda * 2) + Cb[i]; }
        else { oc0[i] = voffA[i]; oc1[i] = voffA[i] + (unsigned)hstepA; }
        on0[i] = oc0[i]; on1[i] = oc1[i]; }
    S.a_ready(cur);
    if constexpr (SP2) {
        PG8_STAGE(PG8_SB(0, 0), cB, voffB); PG8_STAGE(PG8_SB(0, 1), cB + hstepB, voffB); PG8_STAGE(PG8_SA(0, 0), cA, oc0); PG8_STAGE(PG8_SA(0, 1), cA, oc1);
        if (wr == 1) PG8_BAR;
        PG8_WAIT_V(2); PG8_BAR;
        PG8_STAGE(PG8_SB(1, 0), cB + kstep, voffB); PG8_STAGE(PG8_SA(1, 0), cA + kstep, oc0); PG8_STAGE(PG8_SB(1, 1), cB + hstepB + kstep, voffB);
        PG8_WAIT_V(6); PG8_BAR;
    } else {
        PG8_STAGE(PG8_SB(0, 0), cB, voffB); PG8_STAGE(PG8_SA(0, 0), cA, oc0); PG8_STAGE(PG8_SB(0, 1), cB + hstepB, voffB); PG8_STAGE(PG8_SA(0, 1), cA, oc1);
        if (wr == 1) PG8_BAR;
        PG8_WAIT_V(4); PG8_BAR;
        PG8_STAGE(PG8_SB(1, 0), cB + kstep, voffB); PG8_STAGE(PG8_SA(1, 0), cA + kstep, oc0); PG8_STAGE(PG8_SB(1, 1), cB + hstepB + kstep, voffB);
        PG8_WAIT_V(6); PG8_BAR;
    }
    for (;;) {
        const bool has_next = S.next(ui + 1, nxt);
        const char* nA = GATHER ? cA : (has_next ? (const char*)g.A + S.aoff(nxt) : cA); const char* nB = has_next ? (const char*)g.Bt + S.boff(nxt) : cB;
        if constexpr (GATHER) {
#pragma unroll
            for (int i = 0; i < 2; ++i) { if (has_next) { on0[i] = (unsigned)gtab[(ui + 1) * 256 + Rr[i]] * (unsigned)(g.lda * 2) + Cb[i]; on1[i] = (unsigned)gtab[(ui + 1) * 256 + HALF + Rr[i]] * (unsigned)(g.lda * 2) + Cb[i]; } else { on0[i] = oc0[i]; on1[i] = oc1[i]; } } }
        for (int t = 0; t < nt; t += 2) {
            const bool last = (t == nt - 2);
            const char* a1 = cA + (size_t)(t + 1) * kstep;
            const char* a2 = last ? nA : cA + (size_t)(t + 2) * kstep; const char* b2 = last ? nB : cB + (size_t)(t + 2) * kstep;
            unsigned os0[2], os1[2];
#pragma unroll
            for (int i = 0; i < 2; ++i) { os0[i] = (GATHER && last) ? on0[i] : oc0[i]; os1[i] = (GATHER && last) ? on1[i] : oc1[i]; }
            const char* a3 = a2 + kstep; const char* b3 = b2 + kstep;
            if (last && has_next) S.a_ready(nxt);
            if constexpr (SP2) {
            PG8_LDB(B0, 0, 0); PG8_LDB(B1, 0, 1); PG8_SCHED; PG8_LDA(At, 0, 0); PG8_STAGE(PG8_SA(1, 1), a1, oc1);
            PG8_WAIT_V(8); PG8_WAIT_L(0); PG8_BAR; PG8_MMA(0, 0, At, B0); PG8_MMA(0, 1, At, B1); PG8_BAR; PG8_SCHED;
            if constexpr (Epi::DEFER) { if (have_pend) {
                if (t == 0) { E.store_piece(pbase, 0, pend[0]); E.store_piece(pbase, 1, pend[1]); } else if (t == 2) { E.store_piece(pbase, 2, pend[2]); E.store_piece(pbase, 3, pend[3]); }
                else if (t == 4) { E.store_piece(pbase, 4, pend[4]); E.store_piece(pbase, 5, pend[5]); } else if (t == 6) { E.store_piece(pbase, 6, pend[6]); E.store_piece(pbase, 7, pend[7]); have_pend = false; } } }
            PG8_LDA(At, 0, 1); PG8_STAGE(PG8_SB(0, 0), b2, voffB); PG8_STAGE(PG8_SB(0, 1), b2 + hstepB, voffB); PG8_STAGE(PG8_SA(0, 0), a2, os0);
            PG8_WAIT_V(8); PG8_WAIT_L(0); PG8_BAR; PG8_MMA(1, 0, At, B0); PG8_MMA(1, 1, At, B1); PG8_BAR; PG8_SCHED;
            PG8_LDB(B0, 1, 0); PG8_LDB(B1, 1, 1); PG8_SCHED; PG8_LDA(At, 1, 0); PG8_STAGE(PG8_SA(0, 1), a2, os1);
            PG8_WAIT_V(8); PG8_WAIT_L(0); PG8_BAR; PG8_MMA(0, 0, At, B0); PG8_MMA(0, 1, At, B1); PG8_BAR; PG8_SCHED;
            PG8_LDA(At, 1, 1); PG8_STAGE(PG8_SB(1, 0), b3, voffB); PG8_STAGE(PG8_SB(1, 1), b3 + hstepB, voffB); PG8_STAGE(PG8_SA(1, 0), a3, os0);
            PG8_WAIT_V(8); PG8_WAIT_L(0); PG8_BAR; PG8_MMA(1, 0, At, B0); PG8_MMA(1, 1, At, B1); PG8_BAR; PG8_SCHED;
            } else {
            PG8_LDB(B0, 0, 0); PG8_SCHED; PG8_LDA(At, 0, 0); PG8_STAGE(PG8_SA(1, 1), a1, oc1);
            PG8_WAIT_L(8); PG8_BAR; PG8_WAIT_L(0); PG8_MMA(0, 0, At, B0); PG8_BAR; PG8_SCHED;
            PG8_LDB(B1, 0, 1); PG8_STAGE(PG8_SB(0, 0), b2, voffB);
            PG8_BAR; PG8_WAIT_L(0); PG8_MMA(0, 1, At, B1); PG8_BAR;
            PG8_LDA(At, 0, 1); PG8_STAGE(PG8_SA(0, 0), a2, os0);
            PG8_BAR; PG8_WAIT_L(0); PG8_MMA(1, 0, At, B0); PG8_BAR; PG8_SCHED;
            PG8_STAGE(PG8_SB(0, 1), b2 + hstepB, voffB);
            PG8_WAIT_V(6); PG8_BAR; PG8_MMA(1, 1, At, B1); PG8_BAR;
            PG8_LDB(B0, 1, 0); PG8_SCHED; PG8_LDA(At, 1, 0); PG8_STAGE(PG8_SA(0, 1), a2, os1);
            PG8_WAIT_L(8); PG8_BAR; PG8_WAIT_L(0); PG8_MMA(0, 0, At, B0); PG8_BAR; PG8_SCHED;
            PG8_LDB(B1, 1, 1); PG8_STAGE(PG8_SB(1, 0), b3, voffB);
            PG8_BAR; PG8_WAIT_L(0); PG8_MMA(0, 1, At, B1); PG8_BAR;
            PG8_LDA(At, 1, 1); PG8_STAGE(PG8_SA(1, 0), a3, os0);
            PG8_BAR; PG8_WAIT_L(0); PG8_MMA(1, 0, At, B0); PG8_BAR; PG8_SCHED;
            PG8_STAGE(PG8_SB(1, 1), b3 + hstepB, voffB);
            PG8_WAIT_V(6); PG8_BAR; PG8_MMA(1, 1, At, B1); PG8_BAR;
            }
        }
        if constexpr (ALIGN_EPI) { if (wr == 0) PG8_BAR; }
        if constexpr (Epi::DEFER) { pbase = E.pack(acc, cur, wr, wc, fr, fq, pend); have_pend = true; }
        else if constexpr (!Epi::AFTER_DRAIN) { E(acc, cur, wr, wc, fr, fq); S.done(cur); }
        if (!has_next) break;
#pragma unroll
        for (int a = 0; a < 2; ++a)
#pragma unroll
            for (int b = 0; b < 2; ++b)
#pragma unroll
                for (int m = 0; m < 4; ++m)
#pragma unroll
                    for (int n = 0; n < 2; ++n) acc[a][b][m][n] = (f32x4){0.f, 0.f, 0.f, 0.f};
        cur = nxt; cA = nA; cB = nB; ++ui;
#pragma unroll
        for (int i = 0; i < 2; ++i) { oc0[i] = on0[i]; oc1[i] = on1[i]; }
        if constexpr (ALIGN_EPI) { if (wr == 1) PG8_BAR; }
    }
    if constexpr (Epi::DEFER) { if (have_pend) {
#pragma unroll
        for (int i = 0; i < 8; ++i) E.store_piece(pbase, i, pend[i]); } }
    PG8_WAIT_V(0);
    if constexpr (!ALIGN_EPI) { if (wr == 0) PG8_BAR; }
    PG8_BAR;
    if constexpr (Epi::AFTER_DRAIN) { E.fused(acc, cur, wr, wc, fr, fq, lds, wid, lane); S.done(cur); }
#undef PG8_SA
#undef PG8_SB
#undef PG8_STAGE
#undef PG8_LDA
#undef PG8_LDB
#undef PG8_MMA
#undef PG8_WAIT_V
#undef PG8_WAIT_L
#undef PG8_BAR
#undef PG8_SCHED
}

struct SchedDense {
    int nM, nN, nwg, G, c, mode; unsigned lda, ldb, acolb;
    __device__ __forceinline__ void init(int nM_, int nN_, int G_, int c_, int mode_, int lda_, int ldb_, int acolb_) { nM = nM_; nN = nN_; nwg = nM * nN; G = G_; c = c_; mode = mode_; lda = lda_; ldb = ldb_; acolb = acolb_; }
    __device__ __forceinline__ bool next(int i, Unit& u) const {
        const long L = (long)i * G + c; if (L >= nwg) return false;
        int wgid = (int)L; { const int q = nwg / NXCD, r = nwg % NXCD, xcd = wgid % NXCD, off = wgid / NXCD; wgid = (xcd < r ? xcd * (q + 1) : r * (q + 1) + (xcd - r) * q) + off; }
        const int nig = WGM * nN, gid = wgid / nig, fm = gid * WGM, gsz = (nM - fm) < WGM ? (nM - fm) : WGM;
        const int tm = fm + ((wgid % nig) % gsz); u.pn = (wgid % nig) / gsz;
        u.pm = mode ? (tm / 16) * TPB + 1 + (tm % 16) : tm; u.e = 0; u.x = u.pn; return true;
    }
    __device__ __forceinline__ size_t aoff(const Unit& u) const { return (size_t)u.pm * 256 * lda * 2 + (size_t)u.pn * acolb; }
    __device__ __forceinline__ size_t boff(const Unit& u) const { return (size_t)u.pn * 256 * ldb * 2; }
    __device__ __forceinline__ void a_ready(const Unit&) const {}
    __device__ __forceinline__ void done(const Unit&) const {}
};
struct SchedWin {
    int nM, nN, nwg, G, c; long dAB;
    __device__ __forceinline__ void init(int nM_, int G_, int c_, long dAB_) { nM = nM_; nN = 12; nwg = nM * nN; G = G_; c = c_; dAB = dAB_; }
    __device__ __forceinline__ bool next(int i, Unit& u) const {
        const long L = (long)i * G + c; if (L >= nwg) return false;
        int wgid = (int)L; { const int q = nwg / NXCD, r = nwg % NXCD, xcd = wgid % NXCD, off = wgid / NXCD; wgid = (xcd < r ? xcd * (q + 1) : r * (q + 1) + (xcd - r) * q) + off; }
        const int nig = WGM * nN, gid = wgid / nig, fm = gid * WGM, gsz = (nM - fm) < WGM ? (nM - fm) : WGM;
        u.pm = fm + ((wgid % nig) % gsz); u.pn = (wgid % nig) / gsz; u.e = u.pn < 6 ? 1 : 0; u.x = u.pn; return true;
    }
    __device__ __forceinline__ size_t aoff(const Unit& u) const { return u.e ? (size_t)(dAB + (long)u.pn * (256 * 1024 * 2)) : (size_t)u.pm * (256 * 1024 * 2); }
    __device__ __forceinline__ size_t boff(const Unit& u) const { return u.e ? (size_t)(-dAB + (long)u.pm * (256 * 1024 * 2)) : (size_t)u.pn * (256 * 1024 * 2); }
    __device__ __forceinline__ void a_ready(const Unit&) const {}
    __device__ __forceinline__ void done(const Unit&) const {}
};
struct SchedMoe {
    int nPm, nPn, per, G, c, slots, xcd, slot, W; unsigned lda, ldb; int cx;
    __device__ __forceinline__ void init(int nPm_, int nPn_, int G_, int c_, int lda_, int ldb_) { nPm = nPm_; nPn = nPn_; per = nPm * nPn; G = G_; c = c_; lda = lda_; ldb = ldb_; cx = 0;
        slots = G / NXCD; xcd = c % NXCD; slot = c / NXCD; W = nPn < 8 ? nPn : 8; }
    __device__ __forceinline__ bool next(int i, Unit& u) const {
        if (slots == 0) { const long L = (long)i * G + c; if (L >= NE * per) return false; const int e = (int)L / per, rem = (int)L % per; u.e = e; u.x = rem / nPm; u.pm = e * (ME / 256) + rem % nPm; u.pn = e * nPn + u.x; return true; }
        if (slot >= slots) return false;
        if (cx) { if (i > 0 || slot >= 16) return false; const int e = 2 * xcd + (slot >> 3), pnl = (slot >> 1) & 3, kh = slot & 1; u.e = e | (kh << 8); u.x = pnl; u.pm = e * (ME / 256) + (ME / 256 - 1); u.pn = e * nPn + pnl; return true; }
        const int q = i * slots + slot; if (q >= 2 * per) return false;
        const int e = 2 * xcd + q / per, rem = q % per, pnl = W * (rem / (W * nPm)) + rem % W, pml = (rem / W) % nPm;
        u.e = e; u.x = pnl; u.pm = e * (ME / 256) + pml; u.pn = e * nPn + pnl; return true;
    }
    __device__ __forceinline__ size_t aoff(const Unit& u) const { return (size_t)u.pm * 256 * lda * 2 + (size_t)(u.e >> 8) * (lda / 2) * 2; }
    __device__ __forceinline__ size_t boff(const Unit& u) const { return (size_t)u.pn * 256 * ldb * 2 + (size_t)(u.e >> 8) * (ldb / 2) * 2; }
    __device__ __forceinline__ void a_ready(const Unit&) const {}
    __device__ __forceinline__ void done(const Unit&) const {}
};

struct EpiWin {
    static constexpr bool PERM = true, AFTER_DRAIN = false, DEFER = false;
    bf16_t* P; bf16_t* PT; bf16_t* PTC; bf16_t* QB; bf16_t* KB; const float* qg; const float* kg; const PG8_LAS float* cs;
    __device__ __forceinline__ void operator()(const f32x4 (&acc)[2][2][4][2], const Unit& u, int wr, int wc, int fr, int fq) const {
        const int pn = __builtin_amdgcn_readfirstlane(u.pn);
        if (pn >= 6 && pn < 10) {
            const bool isq = pn < 8; bf16_t* OUT = isq ? QB : KB; const float* gg = (isq ? qg : kg) + 8 * fq;
            const int hm = (pn & 1) * 4 + wc, tt = u.pm % TPB; const bool lat = tt != 0, upper = fq >= 2;
            f32x4 g[2][2];
#pragma unroll
            for (int bj = 0; bj < 2; ++bj)
#pragma unroll
                for (int n = 0; n < 2; ++n) g[bj][n] = *(const f32x4*)(gg + 32 * bj + 4 * n);
            const float qs = isq ? 0.18033688011112042f : 1.f;
            const int fi0 = 8 * (fq & 1);
#pragma unroll
            for (int ai = 0; ai < 2; ++ai)
#pragma unroll
                for (int m = 0; m < 4; ++m) { const int rl = ai * HALF + wr * 64 + m * 16 + fr;
                    f32x4 x[2][2]; float ss = 0.f;
#pragma unroll
                    for (int bj = 0; bj < 2; ++bj)
#pragma unroll
                        for (int n = 0; n < 2; ++n) { x[bj][n] = acc[ai][bj][m][n]; ss += (x[bj][n][0] * x[bj][n][0] + x[bj][n][1] * x[bj][n][1]) + (x[bj][n][2] * x[bj][n][2] + x[bj][n][3] * x[bj][n][3]); }
                    ss += __shfl_xor(ss, 16); ss += __shfl_xor(ss, 32);
                    const float rstd = qs / sqrtf(ss * (1.f / 64.f) + 1e-6f);
#pragma unroll
                    for (int bj = 0; bj < 2; ++bj)
#pragma unroll
                        for (int n = 0; n < 2; ++n) x[bj][n] = x[bj][n] * rstd * g[bj][n];
                    if (lat) { const int t = (tt - 1) * 256 + rl;
#pragma unroll
                        for (int bj = 0; bj < 2; ++bj) { const PG8_LAS float* cp = cs + (bj ? (t & 63) : (t >> 6)) * 16 + fi0;
#pragma unroll
                            for (int n = 0; n < 2; ++n) { const f32x4 c4 = *(const PG8_LAS f32x4*)(cp + 4 * n), s4 = *(const PG8_LAS f32x4*)(cp + 1024 + 4 * n);
#pragma unroll
                                for (int j = 0; j < 4; ++j) { const unsigned own = __float_as_uint(x[bj][n][j]); auto rr = __builtin_amdgcn_permlane32_swap(own, own, false, false);
                                    const float other = __uint_as_float(rr[0] ^ rr[1] ^ own);
                                    x[bj][n][j] = upper ? (other * s4[j] + x[bj][n][j] * c4[j]) : (x[bj][n][j] * c4[j] - other * s4[j]); } } } }
                    bf16_t* op = OUT + (size_t)(u.pm * 256 + rl) * 512 + hm * 64 + 8 * fq;
#pragma unroll
                    for (int bj = 0; bj < 2; ++bj) { u32x4 w; w.x = cvt_pk_bf16(x[bj][0][0], x[bj][0][1]); w.y = cvt_pk_bf16(x[bj][0][2], x[bj][0][3]); w.z = cvt_pk_bf16(x[bj][1][0], x[bj][1][1]); w.w = cvt_pk_bf16(x[bj][1][2], x[bj][1][3]);
                        *(u32x4*)(op + 32 * bj) = w; } }
            return;
        }
        bf16_t* base; size_t rstride;
        if (pn < 6) { const int part = pn >> 1, b = u.pm / TPB, tt = u.pm % TPB, c0 = (pn & 1) * 256 + wr * 64 + fr, tl = wc * 32 + 8 * fq;
            if (tt == 0) { rstride = CTX; base = PTC + ((size_t)(part * NB + b) * 512 + c0) * CTX + tl; }
            else { rstride = SEQ; base = PT + ((size_t)(part * NB + b) * 512 + c0) * SEQ + (tt - 1) * 256 + tl; }
        } else { rstride = 512; base = P + (size_t)5 * ((size_t)MT * 512) + (pn & 1) * 256 + wc * 32 + 8 * fq + (size_t)(u.pm * 256 + wr * 64 + fr) * 512; }
#pragma unroll
        for (int ai = 0; ai < 2; ++ai)
#pragma unroll
            for (int m = 0; m < 4; ++m) { bf16_t* rowp = base + (size_t)(ai * HALF + m * 16) * rstride;
#pragma unroll
                for (int bj = 0; bj < 2; ++bj) { const f32x4 v0 = acc[ai][bj][m][0], v1 = acc[ai][bj][m][1]; u32x4 w; w.x = cvt_pk_bf16(v0[0], v0[1]); w.y = cvt_pk_bf16(v0[2], v0[3]); w.z = cvt_pk_bf16(v1[0], v1[1]); w.w = cvt_pk_bf16(v1[2], v1[3]);
                    *(u32x4*)(rowp + bj * HALF) = w; } }
    }
};
struct EpiResid {
    static constexpr bool PERM = true, AFTER_DRAIN = false, DEFER = false;
    h16_t* H; const float* mods_l;
    const float* scale; float dry;
    const float* xin; const float* cin;
    __device__ __forceinline__ void operator()(const f32x4 (&acc)[2][2][4][2], const Unit& u, int wr, int wc, int fr, int fq) const {
        const int b = u.pm / TPB, bb = (u.pm % TPB == 0) ? 8 : b;
        const int col0 = u.x * 256 + wc * 32 + 8 * fq;
        const float* gp = mods_l + (size_t)bb * 6144 + 2 * 1024 + col0;
        h16_t* dbase = H + (size_t)u.pm * 256 * DM;
        const float* sbase = xin ? ((u.pm % TPB == 0) ? cin + (size_t)b * CTX * DM : xin + ((size_t)b * SEQ + (u.pm % TPB - 1) * 256) * DM) : nullptr;
        f32x4 gv[2][2];
#pragma unroll
        for (int bj = 0; bj < 2; ++bj)
#pragma unroll
            for (int n = 0; n < 2; ++n) { gv[bj][n] = *(const f32x4*)(gp + bj * HALF + n * 4) * dry; if (scale) gv[bj][n] = gv[bj][n] * *(const f32x4*)(scale + col0 + bj * HALF + n * 4); }
#pragma unroll
        for (int ai = 0; ai < 2; ++ai)
#pragma unroll
            for (int m = 0; m < 4; ++m) { const unsigned off = (unsigned)(wr * 64 + fr + ai * HALF + m * 16) * DM + (unsigned)col0;
#pragma unroll
                for (int bj = 0; bj < 2; ++bj) { f32x4 s0, s1;
                    if (sbase) { s0 = *(const f32x4*)(sbase + off + bj * HALF); s1 = *(const f32x4*)(sbase + off + bj * HALF + 4); }
                    else { const u32x4 w = *(const u32x4*)(dbase + off + bj * HALF); s0 = h4_f32((u32x2){w.x, w.y}); s1 = h4_f32((u32x2){w.z, w.w}); }
                    const u32x2 o0 = f32_h4(s0 + gv[bj][0] * acc[ai][bj][m][0]), o1 = f32_h4(s1 + gv[bj][1] * acc[ai][bj][m][1]);
                    *(u32x4*)(dbase + off + bj * HALF) = (u32x4){o0.x, o0.y, o1.x, o1.y}; } }
    }
};
struct EpiSwiglu {
    static constexpr bool PERM = true, AFTER_DRAIN = false, DEFER = false;
    bf16_t* ACT;
    __device__ __forceinline__ void operator()(const f32x4 (&acc)[2][2][4][2], const Unit& u, int wr, int wc, int fr, int fq) const {
        const int row0 = u.pm * 256 + wr * 64 + fr, col0 = u.x * 128 + wc * 32 + 8 * fq;
#pragma unroll
        for (int ai = 0; ai < 2; ++ai)
#pragma unroll
            for (int m = 0; m < 4; ++m) { bf16_t* rowp = ACT + (size_t)(row0 + ai * HALF + m * 16) * FF + col0; f32x4 v[2];
#pragma unroll
                for (int n = 0; n < 2; ++n) { const f32x4 g = acc[ai][0][m][n], up = acc[ai][1][m][n];
#pragma unroll
                    for (int j = 0; j < 4; ++j) v[n][j] = g[j] * __builtin_amdgcn_rcpf(1.f + __builtin_amdgcn_exp2f(g[j] * -1.4426950408889634f)) * up[j]; }
                u32x4 w; w.x = cvt_pk_bf16(v[0][0], v[0][1]); w.y = cvt_pk_bf16(v[0][2], v[0][3]); w.z = cvt_pk_bf16(v[1][0], v[1][1]); w.w = cvt_pk_bf16(v[1][2], v[1][3]);
                *(u32x4*)rowp = w; }
    }
};
struct EpiSwigluDefer {
    static constexpr bool PERM = true, AFTER_DRAIN = false, DEFER = true;
    bf16_t* ACT;
    __device__ __forceinline__ bf16_t* pack(const f32x4 (&acc)[2][2][4][2], const Unit& u, int wr, int wc, int fr, int fq, u32x4 (&pend)[8]) const {
        const int row0 = u.pm * 256 + wr * 64 + fr, col0 = u.x * 128 + wc * 32 + 8 * fq;
#pragma unroll
        for (int ai = 0; ai < 2; ++ai)
#pragma unroll
            for (int m = 0; m < 4; ++m) { f32x4 v[2];
#pragma unroll
                for (int n = 0; n < 2; ++n) { const f32x4 g = acc[ai][0][m][n], up = acc[ai][1][m][n];
#pragma unroll
                    for (int j = 0; j < 4; ++j) v[n][j] = g[j] * __builtin_amdgcn_rcpf(1.f + __builtin_amdgcn_exp2f(g[j] * -1.4426950408889634f)) * up[j]; }
                u32x4 w; w.x = cvt_pk_bf16(v[0][0], v[0][1]); w.y = cvt_pk_bf16(v[0][2], v[0][3]); w.z = cvt_pk_bf16(v[1][0], v[1][1]); w.w = cvt_pk_bf16(v[1][2], v[1][3]);
                pend[ai * 4 + m] = w; }
        return ACT + (size_t)row0 * FF + col0;
    }
    __device__ __forceinline__ void store_piece(bf16_t* base, int i, const u32x4& w) const { *(u32x4*)(base + (size_t)((i >> 2) * HALF + (i & 3) * 16) * FF) = w; }
    __device__ __forceinline__ void operator()(const f32x4 (&acc)[2][2][4][2], const Unit& u, int wr, int wc, int fr, int fq) const {}
};
struct EpiDown {
    static constexpr bool PERM = true, AFTER_DRAIN = false, DEFER = false;
    bf16_t* YP; const float* PG; bf16_t* YP2;
    __device__ __forceinline__ void operator()(const f32x4 (&acc)[2][2][4][2], const Unit& u, int wr, int wc, int fr, int fq) const {
        const int row0 = u.pm * 256 + wr * 64 + fr, col0 = u.x * 256 + wc * 32 + 8 * fq;
        bf16_t* Y = (u.e >> 8) ? YP2 + ((long)(u.e & 255) * 256 - (long)u.pm * 256) * DM : YP;
#pragma unroll
        for (int ai = 0; ai < 2; ++ai)
#pragma unroll
            for (int m = 0; m < 4; ++m) { const int row = row0 + ai * HALF + m * 16; const float gt = PG[row]; bf16_t* rowp = Y + (long)row * DM + col0;
#pragma unroll
                for (int bj = 0; bj < 2; ++bj) { const f32x4 v0 = acc[ai][bj][m][0] * gt, v1 = acc[ai][bj][m][1] * gt; u32x4 w; w.x = cvt_pk_bf16(v0[0], v0[1]); w.y = cvt_pk_bf16(v0[2], v0[3]); w.z = cvt_pk_bf16(v1[0], v1[1]); w.w = cvt_pk_bf16(v1[2], v1[3]);
                    *(u32x4*)(rowp + bj * HALF) = w; } }
    }
};
struct EpiNull { static constexpr bool PERM = true, AFTER_DRAIN = false, DEFER = false; int dummy;
    __device__ __forceinline__ void operator()(const f32x4 (&acc)[2][2][4][2], const Unit& u, int wr, int wc, int fr, int fq) const {
#pragma unroll
        for (int ai = 0; ai < 2; ++ai)
#pragma unroll
            for (int bj = 0; bj < 2; ++bj)
#pragma unroll
                for (int m = 0; m < 4; ++m)
#pragma unroll
                    for (int n = 0; n < 2; ++n) { f32x4 t = acc[ai][bj][m][n]; asm volatile("" :: "v"(t)); } } };
}

namespace att {
constexpr int D = 128, NW = 8, QBLK = 32, KVBLK = 64;
constexpr int LDQ = 512, LDK = 512, LDO = 512;
constexpr int NBUF = 4;
constexpr size_t SHM_V = KVBLK * D * 2, SHM_K = KVBLK * D * 2, SHM_ATTN = NBUF * SHM_V + NBUF * SHM_K + NW * 64 * 4;
#define KSWZ(row, colB) ((row) * 256 + ((colB) ^ (((row) & 7) << 4)))
#define SBAR() __builtin_amdgcn_sched_barrier(0)
__device__ __forceinline__ int crow(int r, int hi) { return (r & 3) + 8 * (r >> 2) + 4 * hi; }
__device__ __forceinline__ unsigned cvtpk(float lo, float hi) { unsigned r; asm volatile("v_cvt_pk_bf16_f32 %0, %1, %2" : "=v"(r) : "v"(lo), "v"(hi)); return r; }
__device__ __forceinline__ bf16x8 ld8(const bf16_t* p) { return *reinterpret_cast<const bf16x8*>(p); }

__device__ __forceinline__ void partialSM(f32x16& p0, f32x16& p1, float nb) {
#pragma unroll
  for (int r = 0; r < 16; ++r) p0[r] = __builtin_amdgcn_exp2f(p0[r]);
}
__device__ __forceinline__ void finishSM(f32x16& p0, f32x16& p1, float nb, float& l_reg, bf16x8& pa0, bf16x8& pa1, bf16x8& pa2, bf16x8& pa3) {
#pragma unroll
  for (int r = 0; r < 16; ++r) p1[r] = __builtin_amdgcn_exp2f(p1[r]);
  f32x2 s2 = (f32x2){p0[0], p0[1]} + (f32x2){p1[0], p1[1]};
#pragma unroll
  for (int r = 2; r < 16; r += 2) { s2 = s2 + (f32x2){p0[r], p0[r + 1]}; s2 = s2 + (f32x2){p1[r], p1[r + 1]}; }
  float ps = s2[0] + s2[1];
  { auto rr = __builtin_amdgcn_permlane32_swap(__float_as_uint(ps), __float_as_uint(ps), false, false);
    ps = __uint_as_float(rr[0]) + __uint_as_float(rr[1]); }
  l_reg += ps;
#define PK4(P, BASE, OUT) do { u32x4 w = {cvtpk(P[BASE + 0], P[BASE + 1]), cvtpk(P[BASE + 2], P[BASE + 3]), cvtpk(P[BASE + 4], P[BASE + 5]), cvtpk(P[BASE + 6], P[BASE + 7])}; \
    OUT = *reinterpret_cast<bf16x8*>(&w); } while (0)
  PK4(p0, 0, pa0); PK4(p0, 8, pa1); PK4(p1, 0, pa2); PK4(p1, 8, pa3);
#undef PK4
}
__device__ __forceinline__ void qkt(f32x16& p0, f32x16& p1, const __attribute__((address_space(3))) char* Ks, const bf16x8* qr, int r32, int hi, int mc, const f32x16& negm) {
  bf16x8 kf[8];
#pragma unroll
  for (int d0 = 0; d0 < 4; ++d0) { const int cb = (mc + d0 * 16 + hi * 8) * 2;
    kf[2 * d0] = *(const __attribute__((address_space(3))) bf16x8*)(Ks + KSWZ(r32, cb)); kf[2 * d0 + 1] = *(const __attribute__((address_space(3))) bf16x8*)(Ks + KSWZ(32 + r32, cb)); }
#pragma unroll
  for (int d0 = 0; d0 < 4; ++d0) {
    p0 = __builtin_amdgcn_mfma_f32_32x32x16_bf16(kf[2 * d0], qr[d0], d0 == 0 ? negm : p0, 0, 0, 0);
    p1 = __builtin_amdgcn_mfma_f32_32x32x16_bf16(kf[2 * d0 + 1], qr[d0], d0 == 0 ? negm : p1, 0, 0, 0); }
}
__device__ __forceinline__ int v_st(int k, int c) { const int kk = (k & ~0xC) | ((k & 4) << 1) | ((k & 8) >> 1); return ((kk >> 3) * 4 + (c >> 5)) * 512 + ((kk & 7) * 32 + (c & 31)) * 2; }
__device__ __forceinline__ int v_rd_base(int lane) { return ((lane & 3) << 3) | (((lane >> 2) & 3) << 6) | (((lane >> 4) & 1) << 5) | (((lane >> 5) & 1) << 8); }
constexpr int v_rd_off(int d0, int ks, int half) { return d0 * 512 + ks * 4096 + half * 2048; }
template <int OFF> __device__ __forceinline__ s16x4 tr_read(int vb) {
  s16x4 r; asm volatile("ds_read_b64_tr_b16 %0, %1 offset:%2" : "=&v"(r) : "v"(vb), "i"(OFF) : "memory"); return r;
}
template <int D0, int SO> __device__ __forceinline__ void pv_one(f32x16& od, int vb, bf16x8 pa0, bf16x8 pa1, bf16x8 pa2, bf16x8 pa3) {
  const s16x4 l0 = tr_read<SO + v_rd_off(D0, 0, 0)>(vb), h0 = tr_read<SO + v_rd_off(D0, 0, 1)>(vb), l1 = tr_read<SO + v_rd_off(D0, 1, 0)>(vb), h1 = tr_read<SO + v_rd_off(D0, 1, 1)>(vb);
  const s16x4 l2 = tr_read<SO + v_rd_off(D0, 2, 0)>(vb), h2 = tr_read<SO + v_rd_off(D0, 2, 1)>(vb), l3 = tr_read<SO + v_rd_off(D0, 3, 0)>(vb), h3 = tr_read<SO + v_rd_off(D0, 3, 1)>(vb);
  asm volatile("s_waitcnt lgkmcnt(0)" ::: "memory"); SBAR();
#define PK(L, H) (bf16x8){L[0], L[1], L[2], L[3], H[0], H[1], H[2], H[3]}
  od = __builtin_amdgcn_mfma_f32_32x32x16_bf16(pa0, PK(l0, h0), od, 0, 0, 0);
  od = __builtin_amdgcn_mfma_f32_32x32x16_bf16(pa1, PK(l1, h1), od, 0, 0, 0);
  od = __builtin_amdgcn_mfma_f32_32x32x16_bf16(pa2, PK(l2, h2), od, 0, 0, 0);
  od = __builtin_amdgcn_mfma_f32_32x32x16_bf16(pa3, PK(l3, h3), od, 0, 0, 0);
#undef PK
}
template <int SO = 0> __device__ __forceinline__ void pv_d0(f32x16* o, int vb, bf16x8 pa0, bf16x8 pa1, bf16x8 pa2, bf16x8 pa3) {
  pv_one<0, SO>(o[0], vb, pa0, pa1, pa2, pa3); pv_one<1, SO>(o[1], vb, pa0, pa1, pa2, pa3); pv_one<2, SO>(o[2], vb, pa0, pa1, pa2, pa3); pv_one<3, SO>(o[3], vb, pa0, pa1, pa2, pa3);
}

__device__ __forceinline__ void attn_unit(const bf16_t* __restrict__ Qb, const bf16_t* __restrict__ Kh, const bf16_t* __restrict__ Vh, bf16_t* __restrict__ Ob, float lam, float outscale, const float* __restrict__ subg, float negbound, int seq, char* lds) {
  int tid = threadIdx.x; asm volatile("" : "+v"(tid)); const int wid = tid >> 6, lane = tid & 63, r32 = lane & 31, hi = lane >> 5;
  const int mp = wid >> 2, wq = wid & 3, mc = mp * 64;
  bf16_t* V_lds = (bf16_t*)lds; bf16_t* K_lds = (bf16_t*)(lds + NBUF * SHM_V);
  float* ws = (float*)(lds + NBUF * SHM_V + NBUF * SHM_K) + wid * 64; float* li_l = ws;
  float l_reg = 0; f32x16 o[4] = {}; bf16x8 qr[4];
  f32x16 negm;
#pragma unroll
  for (int r = 0; r < 16; ++r) negm[r] = negbound;
  const bf16_t* Qw = Qb + (long)(wq * QBLK + r32) * LDQ + mc + hi * 8;
#pragma unroll
  for (int d0 = 0; d0 < 4; ++d0) qr[d0] = ld8(Qw + d0 * 16);
  const int vb0 = (int)(uintptr_t)V_lds + v_rd_base(lane);
  const unsigned lds0 = (unsigned)(uintptr_t)lds;
  unsigned ksrc[2], vsrc[2];
#pragma unroll
  for (int i = 0; i < 2; ++i) { const int c = wid * 2 + i;
    { const int row = c * 4 + (lane >> 4), colB = ((lane & 15) << 4) ^ ((row & 7) << 4); ksrc[i] = (unsigned)(row * (LDK * 2) + colB); }
    { const int sub = c * 2 + (lane >> 5), kk = (sub >> 2) * 8 + ((lane & 31) >> 2), k = kk, col = (sub & 3) * 32 + (lane & 3) * 8;
      vsrc[i] = (unsigned)(k * (LDK * 2) + col * 2); } }
  const unsigned kdst = (unsigned)__builtin_amdgcn_readfirstlane(lds0 + NBUF * (unsigned)SHM_V + wid * 2048), vdst = (unsigned)__builtin_amdgcn_readfirstlane(lds0 + wid * 2048);
  const unsigned ks1m = ksrc[1] - 1024u, vs0p = vsrc[0] + 1024u; const char* Vhm = (const char*)Vh - 1024;
#define DMA_TILE(t) do { const size_t go_ = (size_t)(t) * (KVBLK * LDK * 2); const unsigned bo_ = (unsigned)(((t) & 3) * (int)SHM_V); const char* kb_ = (const char*)Kh + go_; const char* vb_ = Vhm + go_; \
    asm volatile("s_mov_b32 m0, %4\n\ts_nop 0\n\tglobal_load_lds_dwordx4 %0, %2\n\tglobal_load_lds_dwordx4 %1, %2 offset:1024\n\ts_mov_b32 m0, %5\n\ts_nop 0\n\tglobal_load_lds_dwordx4 %6, %3\n\tglobal_load_lds_dwordx4 %7, %3 offset:1024" \
        :: "v"(ksrc[0]), "v"(ks1m), "s"(kb_), "s"(vb_), "s"(kdst + bo_), "s"(vdst + bo_), "v"(vs0p), "v"(vsrc[1]) : "memory", "m0"); } while (0)
#define WAITBAR(N) asm volatile("s_waitcnt vmcnt(" #N ") lgkmcnt(0)\n\ts_barrier" ::: "memory")
#define BOFF(t) (((t) & 3) * (int)SHM_V)
  f32x16 pA0, pA1, pB0, pB1; bf16x8 pa0, pa1, pa2, pa3; const int NT = seq / KVBLK;
  DMA_TILE(0); DMA_TILE(1);
  WAITBAR(0);
  if (2 < NT) DMA_TILE(2);
  const __attribute__((address_space(3))) char* K3 = (const __attribute__((address_space(3))) char*)K_lds;
  qkt(pA0, pA1, K3, qr, r32, hi, mc, negm); partialSM(pA0, pA1, negbound);
#define STEP_CT(t, KS, VS, PQ0, PQ1, PP0, PP1) do { if ((t) + 2 < NT) DMA_TILE((t) + 2); \
    SBAR(); qkt(PQ0, PQ1, K3 + (KS) * (int)SHM_K, qr, r32, hi, mc, negm); finishSM(PP0, PP1, negbound, l_reg, pa0, pa1, pa2, pa3); SBAR(); \
    pv_d0<(VS) * (int)SHM_V>(o, vb0, pa0, pa1, pa2, pa3); partialSM(PQ0, PQ1, negbound); \
    if ((t) + 2 < NT) WAITBAR(4); else WAITBAR(0); } while (0)
  int j = 1;
  for (; j + 3 < NT; j += 4) {
    STEP_CT(j, 1, 0, pB0, pB1, pA0, pA1); STEP_CT(j + 1, 2, 1, pA0, pA1, pB0, pB1); STEP_CT(j + 2, 3, 2, pB0, pB1, pA0, pA1); STEP_CT(j + 3, 0, 3, pA0, pA1, pB0, pB1);
  }
  STEP_CT(j, 1, 0, pB0, pB1, pA0, pA1); STEP_CT(j + 1, 2, 1, pA0, pA1, pB0, pB1);
#undef STEP_CT
  SBAR(); qkt(pB0, pB1, K3 + 3 * (int)SHM_K, qr, r32, hi, mc, negm);
  finishSM(pA0, pA1, negbound, l_reg, pa0, pa1, pa2, pa3); SBAR();
  pv_d0<2 * (int)SHM_V>(o, vb0, pa0, pa1, pa2, pa3); partialSM(pB0, pB1, negbound);
  finishSM(pB0, pB1, negbound, l_reg, pa0, pa1, pa2, pa3); SBAR();
  pv_d0<3 * (int)SHM_V>(o, vb0, pa0, pa1, pa2, pa3);
#undef DMA_TILE
#undef WAITBAR
#undef BOFF
  if (hi == 0) li_l[r32] = l_reg; asm volatile("s_waitcnt lgkmcnt(0)" ::: "memory");
  float rli[16];
#pragma unroll
  for (int r = 0; r < 16; ++r) rli[r] = __builtin_amdgcn_rcpf(li_l[crow(r, hi)]);
#pragma unroll
  for (int d0 = 0; d0 < 4; ++d0)
#pragma unroll
    for (int r = 0; r < 16; ++r) o[d0][r] *= rli[r];
  __syncthreads();
  float* X = (float*)lds + wq * 4096;
  if (mp == 1) {
#pragma unroll
    for (int d0 = 0; d0 < 4; ++d0)
#pragma unroll
      for (int r = 0; r < 16; ++r) X[(d0 * 16 + r) * 64 + lane] = o[d0][r]; }
  __syncthreads();
  if (mp == 0) {
    float ss[16];
#pragma unroll
    for (int r = 0; r < 16; ++r) ss[r] = 0.f;
#pragma unroll
    for (int d0 = 0; d0 < 4; ++d0)
#pragma unroll
      for (int r = 0; r < 16; ++r) { const float d = o[d0][r] - lam * X[(d0 * 16 + r) * 64 + lane]; o[d0][r] = d; ss[r] = fmaf(d, d, ss[r]); }
#pragma unroll
    for (int r = 0; r < 16; ++r) { float s = ss[r]; s += __shfl_xor(s, 1); s += __shfl_xor(s, 2); s += __shfl_xor(s, 4); s += __shfl_xor(s, 8); s += __shfl_xor(s, 16);
      ss[r] = outscale / sqrtf(s * (1.f / 128.f) + 1e-6f); }
    bf16_t* Ow = Ob + (long)(wq * QBLK) * 1024;
#pragma unroll
    for (int d0 = 0; d0 < 4; ++d0) { const float gcol = subg[d0 * 32 + r32];
#pragma unroll
      for (int r = 0; r < 16; ++r) { const unsigned w = cvtpk(o[d0][r] * ss[r] * gcol, 0.f); Ow[(long)crow(r, hi) * 1024 + d0 * 32 + r32] = (bf16_t)(w & 0xffffu); } }
  }
  asm volatile("s_waitcnt lgkmcnt(0)\n\ts_barrier" ::: "memory");
}
#undef KSWZ
#undef SBAR
}

struct Params { const float* in[31]; float* out; unsigned char* ws; int ph_lo, ph_hi; };
enum { I_X = 0, I_C, I_CTX, I_CCTX, I_ADAW, I_ADAB, I_NMG, I_NFG, I_WIN, I_WOUT, I_CONVW, I_CONVB, I_FW1, I_FB1, I_FW2, I_FB2, I_FW3, I_FB3, I_FFREQ, I_FWOUT, I_HYBIAS,
       I_QG, I_KG, I_LAMBDA, I_SUBLN, I_POOLW, I_POOLS, I_ROUTER, I_WGATE, I_WUP, I_WDOWN };
typedef const float* cfptr_t;
typedef __attribute__((address_space(4))) const cfptr_t* katab_t;
struct Frame {
    char* lds; int tid, lane, wave, G, bid, gw, NGW;
    katab_t in; unsigned char* ws;
};
#define WSP(T, off) ((T*)(F.ws + (off)))
__device__ __forceinline__ bool moe_split(int G) { return G % 8 == 0 && G / 8 >= 16; }

constexpr int TR_LDS = 64 * 65 * 4;
__device__ __forceinline__ void tr_load(f32x4 (&v)[16], const float* W, int N, int k0, int n0, int lane) {
    const int kr = lane >> 4, nc = lane & 15;
#pragma unroll
    for (int i = 0; i < 16; ++i) v[i] = __builtin_nontemporal_load((const f32x4*)(W + (size_t)(k0 + 4 * i + kr) * N + n0 + 4 * nc));
}
__device__ __forceinline__ void tr_store(const f32x4 (&v)[16], bf16_t* WT, int ldt, int k0, int orow0, float* scr, int lane, int hi_off = 0) {
    const int kr = lane >> 4, nc = lane & 15;
#pragma unroll
    for (int i = 0; i < 16; ++i) { float* d = scr + (4 * i + kr) * 65 + 4 * nc; d[0] = v[i][0]; d[1] = v[i][1]; d[2] = v[i][2]; d[3] = v[i][3]; }
    LDS_WAIT(); asm volatile("" ::: "memory");
    const int nl = lane >> 3, kc = lane & 7;
#pragma unroll
    for (int j = 0; j < 8; ++j) { const int n = nl + 8 * j; const float* s = scr + (8 * kc) * 65 + n;
        u32x4 o; o.x = cvt_pk_bf16(s[0 * 65], s[1 * 65]); o.y = cvt_pk_bf16(s[2 * 65], s[3 * 65]); o.z = cvt_pk_bf16(s[4 * 65], s[5 * 65]); o.w = cvt_pk_bf16(s[6 * 65], s[7 * 65]);
        __builtin_nontemporal_store(o, (u32x4*)(WT + (size_t)(orow0 + n + (j >= 4 ? hi_off : 0)) * ldt + k0 + 8 * kc)); }
    LDS_WAIT(); asm volatile("" ::: "memory");
}
__device__ __forceinline__ void transpose_item(const float* W, int N, bf16_t* WT, int ldt, int k0, int n0, int orow0, float* scr, int lane, int hi_off = 0) {
    f32x4 v[16]; tr_load(v, W, N, k0, n0, lane); tr_store(v, WT, ldt, k0, orow0, scr, lane, hi_off);
}
__device__ __forceinline__ void cvt_matrix(Frame& F, const float* W, int K, int N, bf16_t* WT, int ldt, int orow_base) {
    float* scr = (float*)(F.lds + F.wave * TR_LDS);
    const int nblk = N / 64, nitems = (K / 64) * nblk;
    for (int it = F.gw; it < nitems; it += F.NGW) { const int kb = it / nblk, nb = it % nblk; transpose_item(W, N, WT, ldt, kb * 64, nb * 64, orow_base + nb * 64, scr, F.lane); }
}

__device__ __forceinline__ void norm_mod_store(const f32x4 (&v)[4], float rstd, const float* g, const float* sc, const float* sh, bf16_t* orow, int lane) {
#pragma unroll
    for (int j = 0; j < 4; ++j) { const int col = 4 * lane + 256 * j;
        const f32x4 gg = *(const f32x4*)(g + col), s1 = *(const f32x4*)(sc + col), s0 = *(const f32x4*)(sh + col);
        f32x4 y = v[j] * rstd * gg * (s1 + 1.f) + s0;
        u32x2 w; w.x = cvt_pk_bf16(y[0], y[1]); w.y = cvt_pk_bf16(y[2], y[3]); st8(orow + col, w); }
}
__device__ __forceinline__ float row_rstd(const f32x4 (&v)[4]) {
    float s = 0.f;
#pragma unroll
    for (int j = 0; j < 4; ++j) s += (v[j][0] * v[j][0] + v[j][1] * v[j][1]) + (v[j][2] * v[j][2] + v[j][3] * v[j][3]);
    return 1.f / sqrtf(wave_sum(s) * (1.f / DM) + NORM_EPS);
}
__device__ __forceinline__ int row_bb(int r) { const int b = r / RPB, j = r - b * RPB; return j < CTX ? 8 : b; }

__device__ __forceinline__ void ph_mods(Frame& F) {
    float* s = (float*)F.lds; float* red = s + 9 * 1024;
    const float* c = F.in[I_C]; const float* cc = F.in[I_CCTX]; const float* aw = F.in[I_ADAW]; const float* ab = F.in[I_ADAB]; float* MODS = WSP(float, WS_MODS);
    const int m0 = F.G >= 200 ? 132 : 0, mstep = F.G - m0;
    if (F.bid < m0 || F.bid - m0 >= 4 * 48) return;
    for (int i = F.tid; i < 9 * 1024; i += NTHR) { const int bb = i >> 10, k = i & 1023; const float xv = bb < 8 ? c[bb * 1024 + k] : cc[k]; s[i] = xv / (1.f + expf(-xv)); }
    __syncthreads();
    for (int item = F.bid - m0; item < 4 * 48; item += mstep) {
        const int l = item / 48, cb = item % 48, colc = F.tid & 127, kq = F.tid >> 7;
        const float* W = aw + ((size_t)l * 1024 + kq * 256) * 6144 + cb * 128 + colc;
        float acc[9];
#pragma unroll
        for (int bb = 0; bb < 9; ++bb) acc[bb] = 0.f;
#pragma unroll 32
        for (int k = 0; k < 256; ++k) { const float w = W[(size_t)k * 6144];
#pragma unroll
            for (int bb = 0; bb < 9; ++bb) acc[bb] = fmaf(s[bb * 1024 + kq * 256 + k], w, acc[bb]); }
#pragma unroll
        for (int bb = 0; bb < 9; ++bb) red[(kq * 9 + bb) * 128 + colc] = acc[bb];
        __syncthreads();
        for (int i = F.tid; i < 9 * 128; i += NTHR) { const int bb = i >> 7, c2 = i & 127;
            const float v = (red[(0 * 9 + bb) * 128 + c2] + red[(1 * 9 + bb) * 128 + c2]) + (red[(2 * 9 + bb) * 128 + c2] + red[(3 * 9 + bb) * 128 + c2]) + ab[l * 6144 + cb * 128 + c2];
            MODS[((size_t)l * 9 + bb) * 6144 + cb * 128 + c2] = v; }
        __syncthreads();
    }
}
__device__ __forceinline__ void ph_cvt_small(Frame& F) {
    for (int e = 0; e < 2; ++e) {
        {
          float* scr = (float*)(F.lds + F.wave * TR_LDS); const float* W = F.in[I_WIN] + (size_t)e * 1024 * 3072; bf16_t* WT = WSP(bf16_t, WS_WINT) + (size_t)e * 3072 * 1024;
          for (int it = F.gw; it < 16 * 48; it += F.NGW) { const int kb = it / 48, nb = it % 48, n0 = nb * 64; int orow0 = n0, hi = 0;
              if (n0 >= 1536 && n0 < 2560) { const int r = n0 - 1536; orow0 = 1536 + (r & ~255) + 32 * ((r & 255) >> 6); hi = 96; }
              transpose_item(W, 3072, WT, 1024, kb * 64, n0, orow0, scr, F.lane, hi); } }
        cvt_matrix(F, F.in[I_WOUT] + (size_t)e * 1024 * 1024, 1024, 1024, WSP(bf16_t, WS_WOUTT) + (size_t)e * 1024 * 1024, 1024, 0);
        for (int gi = 0; gi < 4; ++gi) cvt_matrix(F, F.in[I_POOLW] + ((size_t)e * 4 + gi) * 256 * 256, 256, 256, WSP(bf16_t, WS_POOLT) + (size_t)e * 1024 * 256, 256, gi * 256);
    }
}
struct CvtItem { const float* W; bf16_t* WT; int N, ldt, k0, n0, orow0; };
__device__ __forceinline__ CvtItem cvt_expert_item(int it, const float* wg, const float* wu, const float* wd, bf16_t* W13, bf16_t* W2) {
    constexpr int PER = 512;
    const int e = it / (3 * PER), r = it % (3 * PER), which = r / PER, q = r % PER; CvtItem c;
    if (which < 2) { const int nb = q / 16, kb = q % 16, n0 = nb * 64;
        c.W = (which ? wu : wg) + (size_t)e * 1024 * 2048; c.N = 2048; c.WT = W13 + (size_t)e * 4096 * 1024; c.ldt = 1024; c.k0 = kb * 64; c.n0 = n0; c.orow0 = (n0 >> 7) * 256 + (n0 & 127) + which * 128;
    } else { const int nb = q / 32, kb = q % 32;
        c.W = wd + (size_t)e * 2048 * 1024; c.N = 1024; c.WT = W2 + (size_t)e * 1024 * 2048; c.ldt = 2048; c.k0 = kb * 64; c.n0 = nb * 64; c.orow0 = nb * 64; }
    return c;
}
__device__ __forceinline__ void ph_cvt_experts(Frame& F, int l) {
    float* scr = (float*)(F.lds + F.wave * TR_LDS);
    const float* wg = F.in[I_WGATE] + (size_t)l * NE * 1024 * 2048; const float* wu = F.in[I_WUP] + (size_t)l * NE * 1024 * 2048; const float* wd = F.in[I_WDOWN] + (size_t)l * NE * 2048 * 1024;
    bf16_t* W13 = (bf16_t*)(F.ws + WS_W13T + (size_t)(l & 1) * W13T_BYTES); bf16_t* W2 = (bf16_t*)(F.ws + WS_W2T + (size_t)(l & 1) * W2T_BYTES);
    constexpr int NIT = NE * 3 * 512;
    const int per = (NIT + F.NGW - 1) / F.NGW, itend = min(NIT, (F.gw + 1) * per);
#ifndef CVT_NREP
#define CVT_NREP 1
#endif
    int nrep = CVT_NREP; asm volatile("" : "+s"(nrep));
    for (int rep = 0; rep < nrep; ++rep) {
    int it = F.gw * per; if (it >= itend) return;
    f32x4 va[16], vb[16];
    CvtItem ca = cvt_expert_item(it, wg, wu, wd, W13, W2), cb = ca; tr_load(va, ca.W, ca.N, ca.k0, ca.n0, F.lane);
    for (;;) {
        int nit = it + 1; bool more = nit < itend;
        if (more) { cb = cvt_expert_item(nit, wg, wu, wd, W13, W2); tr_load(vb, cb.W, cb.N, cb.k0, cb.n0, F.lane); }
        tr_store(va, ca.WT, ca.ldt, ca.k0, ca.orow0, scr, F.lane);
        if (!more) break;
        it = nit; nit = it + 1; more = nit < itend;
        if (more) { ca = cvt_expert_item(nit, wg, wu, wd, W13, W2); tr_load(va, ca.W, ca.N, ca.k0, ca.n0, F.lane); }
        tr_store(vb, cb.WT, cb.ldt, cb.k0, cb.orow0, scr, F.lane);
        if (!more) break;
        it = nit;
    }
    }
}
__device__ __forceinline__ void ph_filter_mlp(Frame& F) {
    float* zs = (float*)F.lds;
    float* ha = zs + 64 * 33;
    float* hb = ha + 64 * 65;
    float* H3 = WSP(float, WS_FILTF);
    constexpr int NITEM = 64 + 4 + 64;
    const int t = F.tid & 63, wv = F.wave;
    for (int item = F.bid; item < NITEM; item += F.G) {
        int e, L, tb, rowbase;
        if (item < 64) { e = 0; L = SEQ; tb = item; rowbase = 0; }
        else if (item < 68) { e = 0; L = CTX; tb = item - 64; rowbase = SEQ; }
        else { e = 1; L = SEQ; tb = item - 68; rowbase = SEQ + CTX; }
        const int tg = tb * 64 + t;
        const float tlin = (float)tg / (float)(L - 1);
        __syncthreads();
        if (wv == 0) { zs[t * 33] = tlin;
#pragma unroll 1
            for (int k = 0; k < 16; ++k) { const float fk = 1e-4f + (float)k * ((15.f - 1e-4f) / 15.f); const float rev = fk * ((float)tg / (float)L);
                zs[t * 33 + 1 + k] = cos_rev(rev); zs[t * 33 + 17 + k] = -sin_rev(rev); } }
        __syncthreads();
        const float* w1 = F.in[I_FW1] + e * 33 * 64; const float* b1 = F.in[I_FB1] + e * 64; const float* w2 = F.in[I_FW2] + e * 64 * 64; const float* b2 = F.in[I_FB2] + e * 64;
        const float* w3 = F.in[I_FW3] + e * 64 * 64; const float* b3 = F.in[I_FB3] + e * 64; const float* fr = F.in[I_FFREQ] + e * 64;
#pragma unroll 1
        for (int jj = 0; jj < 8; ++jj) { const int j = wv * 8 + jj; float a = b1[j];
#pragma unroll 3
            for (int k = 0; k < 33; ++k) a = fmaf(zs[t * 33 + k], w1[k * 64 + j], a);
            ha[t * 65 + j] = sin_rad(fr[j] * a); }
        __syncthreads();
#pragma unroll 1
        for (int jj = 0; jj < 8; ++jj) { const int j = wv * 8 + jj; float a = b2[j];
#pragma unroll 4
            for (int k = 0; k < 64; ++k) a = fmaf(ha[t * 65 + k], w2[k * 64 + j], a);
            hb[t * 65 + j] = sin_rad(fr[j] * a); }
        __syncthreads();
#pragma unroll 1
        for (int jj = 0; jj < 8; ++jj) { const int j = wv * 8 + jj; float a = b3[j];
#pragma unroll 4
            for (int k = 0; k < 64; ++k) a = fmaf(hb[t * 65 + k], w3[k * 64 + j], a);
            ha[t * 65 + j] = sin_rad(fr[j] * a); }
        __syncthreads();
        for (int i = F.tid; i < 64 * 64; i += NTHR) { const int tt = i >> 6, k = i & 63; H3[(size_t)(rowbase + tb * 64 + tt) * 64 + k] = ha[tt * 65 + k]; }
    }
}
template <bool CTXSET>
__device__ __forceinline__ void gr_item(Frame& F, int e, int o, int c0, const float* h3base, float* wl) {
    constexpr int L = CTXSET ? CTX : SEQ, NIDX = 2 * L;
    const float* wo = F.in[I_FWOUT] + (size_t)e * 64 * 2048; const float* hbias = F.in[I_HYBIAS] + (e * 2 + o) * 512 + c0;
    __syncthreads();
    for (int i = F.tid; i < 8 * 2 * 64; i += NTHR) { const int k = i & 63, dir = (i >> 6) & 1, cl = i >> 7; wl[i] = wo[(size_t)k * 2048 + o * 1024 + dir * 512 + c0 + cl]; }
    __syncthreads();
    for (int idx = F.tid; idx < NIDX; idx += NTHR) {
        const int d = L - idx, t = d < 0 ? -d : d; float val[8];
        if (d == L) {
#pragma unroll
            for (int cl = 0; cl < 8; ++cl) val[cl] = 0.f;
        } else {
            const f32x4* hr = (const f32x4*)(h3base + (size_t)t * 64);
            const float tlin = (float)t / (float)(L - 1);
            const int dir = d < 0 ? 1 : 0; const float* wd_ = wl + dir * 64;
#pragma unroll
            for (int cl = 0; cl < 8; ++cl) val[cl] = 0.f;
#pragma unroll 2
            for (int k4 = 0; k4 < 16; ++k4) { const f32x4 h = hr[k4];
#pragma unroll
                for (int cl = 0; cl < 8; ++cl) { const f32x4 w = *(const f32x4*)(wd_ + cl * 128 + 4 * k4); val[cl] += (h[0] * w[0] + h[1] * w[1]) + (h[2] * w[2] + h[3] * w[3]); } }
            if (d == 0) {
#pragma unroll 1
                for (int k4 = 0; k4 < 16; ++k4) { const f32x4 h = hr[k4];
#pragma unroll
                    for (int cl = 0; cl < 8; ++cl) { const f32x4 w = *(const f32x4*)(wl + 64 + cl * 128 + 4 * k4); val[cl] += (h[0] * w[0] + h[1] * w[1]) + (h[2] * w[2] + h[3] * w[3]); } }
#pragma unroll
                for (int cl = 0; cl < 8; ++cl) val[cl] += hbias[cl]; }
#pragma unroll
            for (int cl = 0; cl < 8; ++cl) { const float delta = fabsf(-3.0701134573253944f + (float)(c0 + cl) * ((-15.350567286626972f + 3.0701134573253944f) / 511.f)); val[cl] *= expf(-tlin * delta); }
        }
        if (CTXSET) { float* GRC = WSP(float, WS_GRC);
#pragma unroll
            for (int cl = 0; cl < 8; ++cl) GRC[((size_t)(c0 + cl) * 2 + o) * 512 + idx] = val[cl];
        } else { bf16_t* GR = WSP(bf16_t, WS_GR);
#pragma unroll
            for (int cl = 0; cl < 8; ++cl) GR[(((size_t)e * 512 + c0 + cl) * 2 + o) * 8192 + idx] = f2bf(val[cl]); }
    }
}
__device__ __forceinline__ void ph_build_gr(Frame& F) {
    float* wl = (float*)F.lds;
    const float* H3 = WSP(float, WS_FILTF);
    for (int item = F.bid; item < 256 + 128; item += F.G) {
        if (item < 256) { const int e = item >> 7, o = (item >> 6) & 1, cb = item & 63; gr_item<false>(F, e, o, cb * 8, H3 + (size_t)(e ? SEQ + CTX : 0) * 64, wl); }
        else { const int v = item - 256, o = v >> 6, cb = v & 63; gr_item<true>(F, 0, o, cb * 8, H3 + (size_t)SEQ * 64, wl); }
    }
}
__device__ __forceinline__ void ph_init_norm_a(Frame& F) {
    const float* x = F.in[I_X]; const float* ctx = F.in[I_CTX];
    bf16_t* A = WSP(bf16_t, WS_ABUF); const float* g = F.in[I_NMG]; const float* mods = WSP(float, WS_MODS);
    constexpr int NR = 4;
    for (int r0 = F.gw; r0 < MT; r0 += NR * F.NGW) {
        f32x4 v[NR][4]; bool ok[NR];
#pragma unroll
        for (int q = 0; q < NR; ++q) { const int r = r0 + q * F.NGW; ok[q] = r < MT;
            if (ok[q]) { const int b = r / RPB, j = r - b * RPB;
                const f32x4* src = (const f32x4*)(j < CTX ? ctx + ((size_t)b * CTX + j) * DM : x + ((size_t)b * SEQ + (j - CTX)) * DM);
#pragma unroll
                for (int jj = 0; jj < 4; ++jj) v[q][jj] = src[F.lane + 64 * jj]; } }
#pragma unroll
        for (int q = 0; q < NR; ++q) { if (!ok[q]) continue;
            const int r = r0 + q * F.NGW, b = r / RPB, j = r - b * RPB;
            const float rstd = row_rstd(v[q]); const float* mb = mods + (size_t)(j < CTX ? 8 : b) * 6144;
            norm_mod_store(v[q], rstd, g, mb + 1024, mb, A + (size_t)r * DM, F.lane); } }
}

__device__ __forceinline__ void ph_qk_post(Frame& F, int e) {
    float* cs = (float*)F.lds;
    for (int i = F.tid; i < 64 * 16; i += NTHR) { const int pos = i >> 4, k = i & 15; const float inv = exp2f(-(float)k * (13.287712379549449f / 16.f)); const float rev = (float)pos * inv * 0.15915494309189535f;
        cs[i] = cos_rev(rev); cs[1024 + i] = sin_rev(rev); }
    __syncthreads();
    const bf16_t* P = WSP(bf16_t, WS_P); bf16_t* QB = WSP(bf16_t, WS_QB); bf16_t* KB = WSP(bf16_t, WS_KB);
    const float* qg = F.in[I_QG] + e * 64; const float* kg = F.in[I_KG] + e * 64;
    const int l8 = F.lane & 7;
    for (int r0 = F.gw; r0 < MT; r0 += 2 * F.NGW) {
        u32x4 raw[2][2]; bool ok[2];
#pragma unroll
        for (int q = 0; q < 2; ++q) { const int r = r0 + q * F.NGW; ok[q] = r < MT;
            if (ok[q]) {
#pragma unroll
                for (int which = 0; which < 2; ++which) raw[q][which] = *(const u32x4*)(P + (size_t)(3 + which) * ((size_t)MT * 512) + (size_t)r * 512 + F.lane * 8); } }
#pragma unroll
        for (int q = 0; q < 2; ++q) { if (!ok[q]) continue;
            const int r = r0 + q * F.NGW, b = r / RPB, j = r - b * RPB; const bool lat = j >= CTX; const int tt = j - CTX, pos = (l8 < 4) ? (tt >> 6) : (tt & 63);
#pragma unroll
            for (int which = 0; which < 2; ++which) { const u32x4 rw_ = raw[q][which];
                float x[8]; x[0] = bflo(rw_.x); x[1] = bfhi(rw_.x); x[2] = bflo(rw_.y); x[3] = bfhi(rw_.y); x[4] = bflo(rw_.z); x[5] = bfhi(rw_.z); x[6] = bflo(rw_.w); x[7] = bfhi(rw_.w);
                float ss = 0.f;
#pragma unroll
                for (int i = 0; i < 8; ++i) ss = fmaf(x[i], x[i], ss);
                ss += __shfl_xor(ss, 1); ss += __shfl_xor(ss, 2); ss += __shfl_xor(ss, 4);
                const float rstd = (which ? 1.f : 0.18033688011112042f) / sqrtf(ss * (1.f / 64.f) + NORM_EPS); const float* gg = (which ? kg : qg) + l8 * 8;
#pragma unroll
                for (int i = 0; i < 8; ++i) x[i] = x[i] * rstd * gg[i];
                float y[8];
#pragma unroll
                for (int i = 0; i < 8; ++i) { const float other = __shfl_xor(x[i], 2);
                    if (lat) { const int fi = (l8 & 1) * 8 + i; const float c = cs[pos * 16 + fi], s = cs[1024 + pos * 16 + fi];
                        y[i] = (l8 & 2) ? (other * s + x[i] * c) : (x[i] * c - other * s); }
                    else y[i] = x[i]; }
                u32x4 w; w.x = cvt_pk_bf16(y[0], y[1]); w.y = cvt_pk_bf16(y[2], y[3]); w.z = cvt_pk_bf16(y[4], y[5]); w.w = cvt_pk_bf16(y[6], y[7]);
                st16((which ? KB : QB) + (size_t)r * 512 + F.lane * 8, w); } }
    }
}
__device__ __forceinline__ void ph_shortconv(Frame& F, int e, bool with_ctx) {
    bf16_t* tin = (bf16_t*)F.lds;
    bf16_t* tout = tin + 258 * 72;
    const bf16_t* P = WSP(bf16_t, WS_P); bf16_t* HYT = WSP(bf16_t, WS_HYT);
    const float* cw = F.in[I_CONVW] + (size_t)e * 3 * 1536; const float* cb = F.in[I_CONVB] + (size_t)e * 1536;
    constexpr int NITEM = NB * 3 * 8 * 16, NCTX = NB * 3 * 8;
    bf16_t* HYC = WSP(bf16_t, WS_HYC);
    for (int item = F.bid; item < NITEM + (with_ctx ? NCTX : 0); item += F.G) {
        const bool isc = item >= NITEM; const int it2 = isc ? (item - NITEM) * 16 : item;
        const int tb = it2 & 15, cbk = (it2 >> 4) & 7, part = (it2 >> 7) % 3, b = it2 / (128 * 3);
        const int t0 = tb * 256, c0 = cbk * 64; const bf16_t* Pp = P + (size_t)part * ((size_t)MT * 512);
        const int SL = isc ? CTX : SEQ, rowb = b * RPB + (isc ? 0 : CTX);
        __syncthreads();
        for (int i = F.tid; i < 258 * 8; i += NTHR) { const int rr = i >> 3, ch = i & 7, t = t0 - 1 + rr; u32x4 v = {0u, 0u, 0u, 0u};
            if (t >= 0 && t < SL) v = *(const u32x4*)(Pp + ((size_t)rowb + t) * 512 + c0 + ch * 8);
            *(u32x4*)(tin + rr * 72 + ch * 8) = v; }
        __syncthreads();
        { const int cl = F.tid & 63, tg = F.tid >> 6, chn = part * 512 + c0 + cl; const float w0 = cw[chn], w1 = cw[1536 + chn], w2 = cw[3072 + chn], bs = cb[chn];
#pragma unroll
          for (int k = 0; k < 4; ++k) { float y[8];
#pragma unroll
            for (int i = 0; i < 8; ++i) { const int rr = (tg * 4 + k) * 8 + i; y[i] = w0 * bf2f(tin[rr * 72 + cl]) + w1 * bf2f(tin[(rr + 1) * 72 + cl]) + w2 * bf2f(tin[(rr + 2) * 72 + cl]) + bs; }
            u32x4 w; w.x = cvt_pk_bf16(y[0], y[1]); w.y = cvt_pk_bf16(y[2], y[3]); w.z = cvt_pk_bf16(y[4], y[5]); w.w = cvt_pk_bf16(y[6], y[7]);
            *(u32x4*)(tout + cl * 264 + (tg * 4 + k) * 8) = w; } }
        __syncthreads();
        for (int i = F.tid; i < 64 * 32; i += NTHR) { const int cl = i >> 5, ch = i & 31; const u32x4 v = *(const u32x4*)(tout + cl * 264 + ch * 8);
          if (isc) st16(HYC + (size_t)part * ((size_t)NB * 512 * CTX) + ((size_t)b * 512 + c0 + cl) * CTX + ch * 8, v);
          else st16(HYT + (size_t)part * ((size_t)NB * 512 * SEQ) + ((size_t)b * 512 + c0 + cl) * SEQ + t0 + ch * 8, v); }
    }
}

constexpr int HY_UST = 4240;
constexpr int HY_GST = 16704;
constexpr int HY_U_BYTES = NB * HY_UST * 2;
__device__ __forceinline__ void hy_load_g(Frame& F, const bf16_t* gr) {
    char* G0 = F.lds + HY_U_BYTES;
    unsigned zz = 0u; asm volatile("" : "+v"(zz));
    for (int q = F.tid; q < 1044; q += NTHR) { u32x4 v = {zz, zz, zz, zz}; if (q >= 8 && q < 1032) v = *(const u32x4*)(gr + (q - 8) * 8); *(u32x4*)(G0 + q * 16) = v; }
    __syncthreads();
    for (int q = F.tid; q < 1040; q += NTHR) { const u32x4 a = *(const u32x4*)(G0 + q * 16), c = *(const u32x4*)(G0 + q * 16 + 16);
        u32x4 o1, o2, o3;
        o1.x = __builtin_amdgcn_alignbit(a.y, a.x, 16); o1.y = __builtin_amdgcn_alignbit(a.z, a.y, 16); o1.z = __builtin_amdgcn_alignbit(a.w, a.z, 16); o1.w = __builtin_amdgcn_alignbit(c.x, a.w, 16);
        o2.x = a.y; o2.y = a.z; o2.z = a.w; o2.w = c.x;
        o3.x = __builtin_amdgcn_alignbit(a.z, a.y, 16); o3.y = __builtin_amdgcn_alignbit(a.w, a.z, 16); o3.z = __builtin_amdgcn_alignbit(c.x, a.w, 16); o3.w = __builtin_amdgcn_alignbit(c.y, c.x, 16);
        *(u32x4*)(G0 + 1 * HY_GST + q * 16) = o1; *(u32x4*)(G0 + 2 * HY_GST + q * 16) = o2; *(u32x4*)(G0 + 3 * HY_GST + q * 16) = o3; }
}
__device__ __forceinline__ void hy_conv(Frame& F, f32x4 (&acc)[16]) {
    const int lane = F.lane, j = lane & 15, q = lane >> 4, n = lane & 15, b = n & 7, sg = n >> 3, tau = F.wave * 512;
    const int r = (4 - (j & 3)) & 3;
    const char* ab0 = F.lds + HY_U_BYTES + r * HY_GST + (4096 - j + 8 * q - r + 64) * 2 - 2 * (tau + 32);
    const char* ub = F.lds + b * (HY_UST * 2) + (16 * sg + 8 * q) * 2;
    bf16x8 W[16];
#define HY_LDA(dst, p) do { const u32x2 lo_ = *(const u32x2*)(p); const u32x2 hi_ = *(const u32x2*)((p) + 8); u32x4 t_ = {lo_.x, lo_.y, hi_.x, hi_.y}; dst = __builtin_bit_cast(bf16x8, t_); } while (0)
#pragma unroll
    for (int i = 0; i < 16; ++i) { acc[i] = (f32x4){0.f, 0.f, 0.f, 0.f}; HY_LDA(W[i], ab0 - 64 * i); }
    { const bf16x8 B = *(const bf16x8*)ub;
#pragma unroll
      for (int i = 0; i < 16; ++i) acc[i] = __builtin_amdgcn_mfma_f32_16x16x32_bf16(W[i], B, acc[i], 0, 0, 0); }
    for (int kb = 0; kb < 8; ++kb) {
#pragma unroll
        for (int kk = 1; kk <= 16; ++kk) { const int k = kb * 16 + kk;
            HY_LDA(W[(16 - kk) & 15], ab0 + 64 * k);
            const bf16x8 B = *(const bf16x8*)(ub + 64 * k);
#pragma unroll
            for (int i = 0; i < 16; ++i) acc[i] = __builtin_amdgcn_mfma_f32_16x16x32_bf16(W[(i - kk + 32) & 15], B, acc[i], 0, 0, 0); }
    }
#undef HY_LDA
}
__device__ __forceinline__ void ph_hyena(Frame& F, int e) {
    bf16_t* HYT = WSP(bf16_t, WS_HYT); const bf16_t* GR = WSP(bf16_t, WS_GR);
    const float* cw = F.in[I_CONVW] + (size_t)e * 3 * 1536; const float* cb = F.in[I_CONVB] + (size_t)e * 1536;
    const int lane = F.lane, q = lane >> 4, n = lane & 15, b = n & 7, sg = n >> 3, tau = F.wave * 512;
    for (int c = F.bid; c < 512; c += F.G) {
        __syncthreads();
        { const bf16_t* src = HYT + 2 * ((size_t)NB * 512 * SEQ) + ((size_t)F.wave * 512 + c) * SEQ; char* urow = F.lds + F.wave * (HY_UST * 2);
          const float w0 = cw[1024 + c], w1 = cw[1536 + 1024 + c], w2 = cw[3072 + 1024 + c], bs = cb[1024 + c];
#pragma unroll
          for (int i = 0; i < 8; ++i) { const int ch = lane + 64 * i; const u32x4 raw = *(const u32x4*)(src + ch * 8);
              float x[10]; x[0] = ch > 0 ? bf2f(src[ch * 8 - 1]) : 0.f; x[9] = ch < 511 ? bf2f(src[ch * 8 + 8]) : 0.f;
              x[1] = bflo(raw.x); x[2] = bfhi(raw.x); x[3] = bflo(raw.y); x[4] = bfhi(raw.y); x[5] = bflo(raw.z); x[6] = bfhi(raw.z); x[7] = bflo(raw.w); x[8] = bfhi(raw.w);
              float y[8];
#pragma unroll
              for (int k = 0; k < 8; ++k) y[k] = w0 * x[k] + w1 * x[k + 1] + w2 * x[k + 2] + bs;
              u32x4 w; w.x = cvt_pk_bf16(y[0], y[1]); w.y = cvt_pk_bf16(y[2], y[3]); w.z = cvt_pk_bf16(y[4], y[5]); w.w = cvt_pk_bf16(y[6], y[7]);
              *(u32x4*)(urow + 64 + ch * 16) = w; }
          unsigned zz = 0u; asm volatile("" : "+v"(zz)); const u32x4 zv = {zz, zz, zz, zz};
          if (lane < 4) *(u32x4*)(urow + lane * 16) = zv;
          if (lane >= 8 && lane < 22) *(u32x4*)(urow + 64 + 8192 + (lane - 8) * 16) = zv; }
        hy_load_g(F, GR + (((size_t)e * 512 + c) * 2 + 0) * 8192);
        __syncthreads();
        f32x4 acc[16];
        hy_conv(F, acc);
        __syncthreads();
#define HY_GATE(GP, W0, W1, W2, BS, T, G4) do { const u32x2 gw_ = *(const u32x2*)((GP) + (T)); const float xm_ = (T) > 0 ? bf2f((GP)[(T) - 1]) : 0.f, xp_ = (T) + 4 < SEQ ? bf2f((GP)[(T) + 4]) : 0.f; \
            const float x0_ = bflo(gw_.x), x1_ = bfhi(gw_.x), x2_ = bflo(gw_.y), x3_ = bfhi(gw_.y); \
            G4[0] = W0 * xm_ + W1 * x0_ + W2 * x1_ + BS; G4[1] = W0 * x0_ + W1 * x1_ + W2 * x2_ + BS; G4[2] = W0 * x1_ + W1 * x2_ + W2 * x3_ + BS; G4[3] = W0 * x2_ + W1 * x3_ + W2 * xp_ + BS; } while (0)
        { const bf16_t* gate = HYT + 0 * ((size_t)NB * 512 * SEQ) + ((size_t)b * 512 + c) * SEQ; char* urow = F.lds + b * (HY_UST * 2);
          const float w0 = cw[c], w1 = cw[1536 + c], w2 = cw[3072 + c], bs = cb[c];
#pragma unroll
          for (int i = 0; i < 16; ++i) { const int t = tau + 32 * i + 16 * sg + 4 * q; float g4[4]; HY_GATE(gate, w0, w1, w2, bs, t, g4);
              u32x2 w; w.x = cvt_pk_bf16(acc[i][0] * g4[0], acc[i][1] * g4[1]); w.y = cvt_pk_bf16(acc[i][2] * g4[2], acc[i][3] * g4[3]);
              *(u32x2*)(urow + (32 + t) * 2) = w; } }
        hy_load_g(F, GR + (((size_t)e * 512 + c) * 2 + 1) * 8192);
        __syncthreads();
        hy_conv(F, acc);
        { const bf16_t* gate = HYT + 1 * ((size_t)NB * 512 * SEQ) + ((size_t)b * 512 + c) * SEQ; bf16_t* dst = HYT + 3 * ((size_t)NB * 512 * SEQ) + ((size_t)b * 512 + c) * SEQ;
          const float w0 = cw[512 + c], w1 = cw[1536 + 512 + c], w2 = cw[3072 + 512 + c], bs = cb[512 + c];
#pragma unroll
          for (int i = 0; i < 16; ++i) { const int t = tau + 32 * i + 16 * sg + 4 * q; float g4[4]; HY_GATE(gate, w0, w1, w2, bs, t, g4);
              u32x2 w; w.x = cvt_pk_bf16(acc[i][0] * g4[0], acc[i][1] * g4[1]); w.y = cvt_pk_bf16(acc[i][2] * g4[2], acc[i][3] * g4[3]);
              *(u32x2*)(dst + t) = w; } }
#undef HY_GATE
    }
}
__device__ __forceinline__ void ph_hyena_ctx(Frame& F, int e) {
    float* us = (float*)(F.lds) + F.wave * 768;
    float* gs = us + 256;
    const bf16_t* HYC = WSP(bf16_t, WS_HYC); const float* GRC = WSP(float, WS_GRC); bf16_t* A = WSP(bf16_t, WS_ABUF);
    const float* cw = F.in[I_CONVW] + (size_t)e * 3 * 1536; const float* cb = F.in[I_CONVB] + (size_t)e * 1536;
    for (int item = F.gw; item < NB * 512; item += F.NGW) { const int b = item >> 9, c = item & 511;
        float xg[2][4], v[4];
#pragma unroll
        for (int part = 0; part < 3; ++part) { const u32x2 w = *(const u32x2*)(HYC + (size_t)part * ((size_t)NB * 512 * CTX) + ((size_t)b * 512 + c) * CTX + F.lane * 4);
            const int chn = part * 512 + c; const float w0 = cw[chn], w1 = cw[1536 + chn], w2 = cw[3072 + chn], bs = cb[chn];
            const float x0 = bflo(w.x), x1 = bfhi(w.x), x2 = bflo(w.y), x3 = bfhi(w.y);
            float xm = __shfl_up(x3, 1), xp = __shfl_down(x0, 1); if (F.lane == 0) xm = 0.f; if (F.lane == 63) xp = 0.f;
            const float y0 = w0 * xm + w1 * x0 + w2 * x1 + bs, y1 = w0 * x0 + w1 * x1 + w2 * x2 + bs, y2 = w0 * x1 + w1 * x2 + w2 * x3 + bs, y3 = w0 * x2 + w1 * x3 + w2 * xp + bs;
            if (part == 0) { xg[0][0] = y0; xg[0][1] = y1; xg[0][2] = y2; xg[0][3] = y3; } else if (part == 1) { xg[1][0] = y0; xg[1][1] = y1; xg[1][2] = y2; xg[1][3] = y3; } else { v[0] = y0; v[1] = y1; v[2] = y2; v[3] = y3; } }
#pragma unroll
        for (int o = 0; o < 2; ++o) {
            LDS_WAIT(); __builtin_amdgcn_wave_barrier();
#pragma unroll
            for (int i = 0; i < 4; ++i) us[F.lane * 4 + i] = v[i];
#pragma unroll
            for (int i = 0; i < 8; ++i) gs[F.lane + 64 * i] = GRC[((size_t)c * 2 + o) * 512 + F.lane + 64 * i];
            LDS_WAIT(); __builtin_amdgcn_wave_barrier();
            float y[4] = {0.f, 0.f, 0.f, 0.f};
            for (int s = 0; s < CTX; ++s) { const float uv = us[s];
#pragma unroll
                for (int i = 0; i < 4; ++i) y[i] = fmaf(gs[256 - (F.lane * 4 + i) + s], uv, y[i]); }
#pragma unroll
            for (int i = 0; i < 4; ++i) v[i] = xg[o][i] * y[i];
        }
#pragma unroll
        for (int i = 0; i < 4; ++i) A[((size_t)b * RPB + F.lane * 4 + i) * DM + c] = f2bf(v[i]);
    }
}
__device__ __forceinline__ void ph_attn(Frame& F, int e, int l, bool with_ctx, int i0, int i1) {
    const bf16_t* QB = WSP(bf16_t, WS_QB); const bf16_t* KB = WSP(bf16_t, WS_KB); const bf16_t* VB = WSP(bf16_t, WS_P) + 5 * ((size_t)MT * 512); bf16_t* A = WSP(bf16_t, WS_ABUF);
    const float* lv = F.in[I_LAMBDA] + e * 4 * 64; const float lam_init = 0.8f - 0.6f * expf(-0.3f * (float)l);
    const float* sg = F.in[I_SUBLN] + e * 128;
    int ln = F.lane; asm volatile("" : "+v"(ln));
    float mq = fabsf(F.in[I_QG][e * 64 + ln]), mk = fabsf(F.in[I_KG][e * 64 + ln]);
#pragma unroll
    for (int o = 1; o < 64; o <<= 1) { mq = fmaxf(mq, __shfl_xor(mq, o)); mk = fmaxf(mk, __shfl_xor(mk, o)); }
    const float lam = expf(wave_sum(lv[ln] * lv[64 + ln])) - expf(wave_sum(lv[128 + ln] * lv[192 + ln])) + lam_init;
    const float negbound = -(8.f * 1.4426950408889634f) * mq * mk * 1.0001f;
    const float lam_s = __builtin_bit_cast(float, __builtin_amdgcn_readfirstlane(__builtin_bit_cast(int, lam))), nb_s = __builtin_bit_cast(float, __builtin_amdgcn_readfirstlane(__builtin_bit_cast(int, negbound))),
                osc_s = __builtin_bit_cast(float, __builtin_amdgcn_readfirstlane(__builtin_bit_cast(int, 1.f - lam_init)));
    const int nun = NB * 4 * 32 + (with_ctx ? NB * 4 * 2 : 0);
    const int vcu = (F.G % 8 == 0) ? (F.bid % 8) * (F.G / 8) + F.bid / 8 : F.bid;
    for (int i = i0; i < i1; ++i) { const int u = vcu + i * F.G; if (u >= nun) break;
        int b, h, row0, seq;
        if (u < NB * 4 * 32) { const int bh = u >> 5, qb = u & 31; b = bh >> 2; h = bh & 3; row0 = b * RPB + CTX + qb * 128; seq = RPB; }
        else { const int v = u - NB * 4 * 32, bh = v >> 1, qb = v & 1; b = bh >> 2; h = bh & 3; row0 = b * RPB + qb * 128; seq = CTX; }
        const size_t kbase = (size_t)b * RPB * 512 + h * 128, qbase = (size_t)row0 * 512 + h * 128;
        att::attn_unit(QB + qbase, KB + kbase, VB + kbase, A + (size_t)row0 * DM + 512 + h * 128, lam_s, osc_s, sg, nb_s, seq, F.lds);
    }
}
__device__ __forceinline__ void ph_mix(Frame& F, int e, int l, bool with_ctx) {
    bf16_t* A = WSP(bf16_t, WS_ABUF);
    { bf16_t* tl = (bf16_t*)F.lds;
      const bf16_t* HY = WSP(bf16_t, WS_HYT) + 3 * ((size_t)NB * 512 * SEQ);
      const int cl = F.tid >> 3, ch = F.tid & 7; constexpr int NIT = NB * 8 * 64;
      auto src = [&](int item) { const int tb = item & 63, cbk = (item >> 6) & 7, b = item >> 9; return (const u32x4*)(HY + ((size_t)b * 512 + cbk * 64 + cl) * SEQ + tb * 64 + ch * 8); };
      u32x4 cur = {0u, 0u, 0u, 0u}; if (F.bid < NIT) cur = *src(F.bid);
      for (int item = F.bid; item < NIT; item += F.G) { const int tb = item & 63, cbk = (item >> 6) & 7, b = item >> 9, t0 = tb * 64, c0 = cbk * 64;
          u32x4 nxt = {0u, 0u, 0u, 0u}; if (item + F.G < NIT) nxt = *src(item + F.G);
          asm volatile("s_waitcnt lgkmcnt(0)\n\ts_barrier" ::: "memory");
          *(u32x4*)(tl + cl * 72 + ch * 8) = cur;
          asm volatile("s_waitcnt lgkmcnt(0)\n\ts_barrier" ::: "memory");
          { const int tloc = F.tid >> 3, cc = F.tid & 7; unsigned short v[8];
#pragma unroll
            for (int i = 0; i < 8; ++i) v[i] = tl[(cc * 8 + i) * 72 + tloc];
            u32x4 w; w.x = v[0] | ((unsigned)v[1] << 16); w.y = v[2] | ((unsigned)v[3] << 16); w.z = v[4] | ((unsigned)v[5] << 16); w.w = v[6] | ((unsigned)v[7] << 16);
            st16(A + ((size_t)b * RPB + CTX + t0 + tloc) * DM + c0 + cc * 8, w); }
          cur = nxt; } }
}

__device__ __forceinline__ void ph_router(Frame& F, int l, bool with_ctx) {
    float* rw = (float*)F.lds;
    const float* R = F.in[I_ROUTER] + (size_t)l * DM * NE;
    __syncthreads();
    for (int i = F.tid; i < DM * NE; i += NTHR) { const int col = i >> 4, ex = i & 15; rw[ex * DM + col] = R[i]; }
    __syncthreads();
    const h16_t* H = WSP(h16_t, WS_H); float* AFF = WSP(float, WS_AFF); bf16_t* FIN = WSP(bf16_t, WS_XS);
    const float* g = F.in[I_NFG] + l * DM; const float* mods = WSP(float, WS_MODS) + (size_t)l * 9 * 6144;
    const int lane = F.lane, ex = ((lane >> 5) & 1) * 8 + ((lane >> 4) & 1) * 4 + ((lane >> 3) & 1) * 2 + ((lane >> 2) & 1);
    for (int r0 = F.gw; r0 < MT; r0 += 2 * F.NGW) {
        f32x4 v[2][4]; bool ok[2]; int rb[2], rj[2];
#pragma unroll
        for (int q = 0; q < 2; ++q) { const int r = r0 + q * F.NGW; rb[q] = r / RPB; rj[q] = r - rb[q] * RPB; ok[q] = r < MT && !(rj[q] < CTX && !with_ctx);
#pragma unroll
            for (int jj = 0; jj < 4; ++jj) v[q][jj] = (f32x4){0.f, 0.f, 0.f, 0.f};
            if (ok[q]) { const u32x2* src = (const u32x2*)(H + (size_t)r * DM);
#pragma unroll
                for (int jj = 0; jj < 4; ++jj) v[q][jj] = h4_f32(src[lane + 64 * jj]); } }
#pragma unroll
        for (int q = 0; q < 2; ++q) { if (!ok[q]) continue;
            const int r = r0 + q * F.NGW, b = rb[q], j = rj[q];
            const float rstd = row_rstd(v[q]); const float* mb = mods + (size_t)(j < CTX ? 8 : b) * 6144;
#pragma unroll
            for (int jj = 0; jj < 4; ++jj) { const int col = 4 * lane + 256 * jj; const f32x4 gg = *(const f32x4*)(g + col), s1 = *(const f32x4*)(mb + 4 * 1024 + col), s0 = *(const f32x4*)(mb + 3 * 1024 + col);
                v[q][jj] = v[q][jj] * rstd * gg * (s1 + 1.f) + s0; }
            { bf16_t* fo = FIN + (size_t)r * DM;
#pragma unroll
              for (int jj = 0; jj < 4; ++jj) { u32x2 w; w.x = cvt_pk_bf16(v[q][jj][0], v[q][jj][1]); w.y = cvt_pk_bf16(v[q][jj][2], v[q][jj][3]); st8(fo + 4 * lane + 256 * jj, w); } } }
        float a[2][16]; int lo4 = 4 * lane; asm volatile("" : "+v"(lo4)); const float* rwl = rw + lo4;
#pragma unroll
        for (int e2 = 0; e2 < 16; ++e2) { float t0 = 0.f, t1 = 0.f;
#pragma unroll
            for (int jj = 0; jj < 4; ++jj) { const f32x4 w = *(const f32x4*)(rwl + e2 * DM + 256 * jj);
                t0 += (v[0][jj][0] * w[0] + v[0][jj][1] * w[1]) + (v[0][jj][2] * w[2] + v[0][jj][3] * w[3]);
                t1 += (v[1][jj][0] * w[0] + v[1][jj][1] * w[1]) + (v[1][jj][2] * w[2] + v[1][jj][3] * w[3]); }
            if ((e2 & 3) == 3) asm volatile("" : "+v"(t0), "+v"(t1), "+v"(a[0][e2 - 1]), "+v"(a[1][e2 - 1]), "+v"(a[0][e2 - 2]), "+v"(a[1][e2 - 2]), "+v"(a[0][e2 - 3]), "+v"(a[1][e2 - 3]) :: "memory");
            a[0][e2] = t0; a[1][e2] = t1; }
#pragma unroll
        for (int q = 0; q < 2; ++q) {
            const int b = rb[q], j = rj[q];
#pragma unroll
            for (int i = 0; i < 8; ++i) { const bool hb = lane & 32; const float keep = hb ? a[q][8 + i] : a[q][i], send = hb ? a[q][i] : a[q][8 + i]; a[q][i] = keep + __shfl_xor(send, 32); }
#pragma unroll
            for (int i = 0; i < 4; ++i) { const bool hb = lane & 16; const float keep = hb ? a[q][4 + i] : a[q][i], send = hb ? a[q][i] : a[q][4 + i]; a[q][i] = keep + __shfl_xor(send, 16); }
#pragma unroll
            for (int i = 0; i < 2; ++i) { const bool hb = lane & 8; const float keep = hb ? a[q][2 + i] : a[q][i], send = hb ? a[q][i] : a[q][2 + i]; a[q][i] = keep + __shfl_xor(send, 8); }
            { const bool hb = lane & 4; const float keep = hb ? a[q][1] : a[q][0], send = hb ? a[q][0] : a[q][1]; a[q][0] = keep + __shfl_xor(send, 4); }
            float lgt = a[q][0]; lgt += __shfl_xor(lgt, 2); lgt += __shfl_xor(lgt, 1);
            float mx = lgt;
#pragma unroll
            for (int o = 4; o < 64; o <<= 1) mx = fmaxf(mx, __shfl_xor(mx, o));
            const float ev = expf(lgt - mx); float se = ev;
#pragma unroll
            for (int o = 4; o < 64; o <<= 1) se += __shfl_xor(se, o);
            if (ok[q] && (lane & 3) == 0) AFF[((size_t)b * NE + ex) * RPB + j] = ev / se; }
    }
}
__device__ __forceinline__ void ph_topk(Frame& F, bool with_ctx) {
    unsigned* cnt = (unsigned*)F.lds;
    const float* AFF = WSP(float, WS_AFF); int* TOK = WSP(int, WS_TOKROW); float* PG = WSP(float, WS_PGATE); int* SLOT = WSP(int, WS_SLOT);
    const int nprob = NB * NE * (with_ctx ? 2 : 1);
    for (int pr = F.bid; pr < nprob; pr += F.G) {
        const int kind = pr / (NB * NE), be = pr % (NB * NE), b = be / NE, e = be % NE;
        const int n = kind ? CTX : SEQ, cap = kind ? CAPC : CAPL, j0 = kind ? 0 : CTX;
        const float* av = AFF + ((size_t)b * NE + e) * RPB + j0;
        unsigned key[8];
#pragma unroll
        for (int k = 0; k < 8; ++k) { const int idx = F.tid * 8 + k; key[k] = idx < n ? __float_as_uint(av[idx]) : 0u; }
        const bool act = F.tid * 8 < n;
        unsigned T = 0u; int it = 0;
#pragma unroll 1
        for (int bit = 30; bit >= 0; --bit, ++it) { const unsigned cand = T | (1u << bit); unsigned c = 0u;
#pragma unroll
            for (int k = 0; k < 8; ++k) c += (unsigned)__builtin_popcountll(__ballot(act && key[k] >= cand));
            unsigned* slot = cnt + (it & 1) * 8; if (F.lane == 0) slot[F.wave] = c;
            __syncthreads();
            unsigned tot = 0u;
#pragma unroll
            for (int w = 0; w < 8; ++w) tot += slot[w];
            if (tot >= (unsigned)cap) T = cand; }
        __syncthreads();
        unsigned gt = 0u, eq = 0u;
#pragma unroll
        for (int k = 0; k < 8; ++k) { gt += (act && key[k] > T) ? 1u : 0u; eq += (act && key[k] == T) ? 1u : 0u; }
        unsigned eqx = eq, gts = gt;
#pragma unroll
        for (int o = 1; o < 64; o <<= 1) { const unsigned t = __shfl_up(eqx, o); if (F.lane >= o) eqx += t; gts += __shfl_xor(gts, o); }
        if (F.lane == 63) cnt[16 + F.wave] = eqx; if (F.lane == 0) cnt[24 + F.wave] = gts;
        __syncthreads();
        unsigned eqbase = 0u, gttot = 0u;
#pragma unroll
        for (int w = 0; w < 8; ++w) { if (w < F.wave) eqbase += cnt[16 + w]; gttot += cnt[24 + w]; }
        const unsigned need = (unsigned)cap - gttot;
        unsigned eqrank = eqbase + eqx - eq;
        unsigned sel = 0u, selmask = 0u;
#pragma unroll
        for (int k = 0; k < 8; ++k) { bool s = act && key[k] > T; if (act && key[k] == T) { s = eqrank < need; ++eqrank; } if (s) { ++sel; selmask |= 1u << k; } }
        unsigned sx = sel;
#pragma unroll
        for (int o = 1; o < 64; o <<= 1) { const unsigned t = __shfl_up(sx, o); if (F.lane >= o) sx += t; }
        __syncthreads();
        if (F.lane == 63) cnt[16 + F.wave] = sx;
        __syncthreads();
        unsigned sbase = 0u;
#pragma unroll
        for (int w = 0; w < 8; ++w) if (w < F.wave) sbase += cnt[16 + w];
        unsigned pos = sbase + sx - sel;
        const int rrbase = kind ? NB * CAPL + b * CAPC : b * CAPL;
#pragma unroll
        for (int k = 0; k < 8; ++k) { const int idx = F.tid * 8 + k; if (idx < n) { int sl = -1;
                if (selmask & (1u << k)) { sl = rrbase + (int)pos; TOK[(size_t)e * ME + sl] = b * RPB + j0 + idx; PG[(size_t)e * ME + sl] = __uint_as_float(key[k]); ++pos; }
                SLOT[((size_t)b * RPB + j0 + idx) * NE + e] = sl; } }
        __syncthreads();
    }
}
__device__ __forceinline__ void ph_combine(Frame& F, int l, bool with_ctx, bool dry = false) {
    const bool split = with_ctx && moe_split(F.G); const bf16_t* YP2 = WSP(bf16_t, WS_OBUF);
    h16_t* H = WSP(h16_t, WS_H); const int* SLOT = WSP(int, WS_SLOT); const bf16_t* YP = WSP(bf16_t, WS_YP); bf16_t* A = WSP(bf16_t, WS_ABUF);
    const float* mods = WSP(float, WS_MODS) + (size_t)l * 9 * 6144; const float* modsn = mods + 9 * 6144; const float* gn = F.in[I_NMG] + (l + 1) * DM; float* out = ((float*)F.in[31]);
    const int lane = F.lane;
    constexpr int NR = 4;
    for (int r0 = F.gw; r0 < MT; r0 += NR * F.NGW) {
        int rb[NR], rj[NR], myslot[NR]; bool ok[NR]; u32x2 hv[NR][4];
#pragma unroll
        for (int q = 0; q < NR; ++q) { const int r = r0 + q * F.NGW; rb[q] = r / RPB; rj[q] = r - rb[q] * RPB; ok[q] = r < MT && !(rj[q] < CTX && !with_ctx); myslot[q] = -1;
            if (ok[q]) { myslot[q] = SLOT[((size_t)rb[q] * RPB + rj[q]) * NE + (lane & 15)]; const u32x2* hp = (const u32x2*)(H + (size_t)r * DM);
#pragma unroll
                for (int jj = 0; jj < 4; ++jj) hv[q][jj] = hp[lane + 64 * jj]; } }
#pragma unroll
        for (int q = 0; q < NR; ++q) { if (!ok[q]) continue;
            const int r = r0 + q * F.NGW, b = rb[q], j = rj[q]; const bool isctx = j < CTX;
            f32x4 s[4];
#pragma unroll
            for (int jj = 0; jj < 4; ++jj) s[jj] = (f32x4){0.f, 0.f, 0.f, 0.f};
            unsigned long long msk = __ballot(myslot[q] >= 0) & 0xffffull; if (dry) msk = 0ull;
            while (msk) {
                const int e0 = __builtin_ctzll(msk); msk &= msk - 1; const int sl0 = __builtin_amdgcn_readlane(myslot[q], e0);
                const u32x2* yp0 = (const u32x2*)(YP + ((size_t)e0 * ME + sl0) * DM);
                if (msk) { const int e1 = __builtin_ctzll(msk); msk &= msk - 1; const int sl1 = __builtin_amdgcn_readlane(myslot[q], e1);
                    const u32x2* yp1 = (const u32x2*)(YP + ((size_t)e1 * ME + sl1) * DM); u32x2 w0[4], w1[4];
#pragma unroll
                    for (int jj = 0; jj < 4; ++jj) { w0[jj] = __builtin_nontemporal_load(yp0 + lane + 64 * jj); w1[jj] = __builtin_nontemporal_load(yp1 + lane + 64 * jj); }
#pragma unroll
                    for (int jj = 0; jj < 4; ++jj) { s[jj][0] += bflo(w0[jj].x); s[jj][1] += bfhi(w0[jj].x); s[jj][2] += bflo(w0[jj].y); s[jj][3] += bfhi(w0[jj].y);
                        s[jj][0] += bflo(w1[jj].x); s[jj][1] += bfhi(w1[jj].x); s[jj][2] += bflo(w1[jj].y); s[jj][3] += bfhi(w1[jj].y); }
                } else {
#pragma unroll
                    for (int jj = 0; jj < 4; ++jj) { const u32x2 w = __builtin_nontemporal_load(yp0 + lane + 64 * jj); s[jj][0] += bflo(w.x); s[jj][1] += bfhi(w.x); s[jj][2] += bflo(w.y); s[jj][3] += bfhi(w.y); } }
            }
            if (split && isctx) {
                unsigned long long m2 = __ballot(myslot[q] >= 0) & 0xffffull; if (dry) m2 = 0ull;
                while (m2) { const int e0 = __builtin_ctzll(m2); m2 &= m2 - 1; const int sl0 = __builtin_amdgcn_readlane(myslot[q], e0) - NB * CAPL;
                    const u32x2* yp0 = (const u32x2*)(YP2 + ((size_t)e0 * 256 + sl0) * DM);
#pragma unroll
                    for (int jj = 0; jj < 4; ++jj) { const u32x2 w = __builtin_nontemporal_load(yp0 + lane + 64 * jj); s[jj][0] += bflo(w.x); s[jj][1] += bfhi(w.x); s[jj][2] += bflo(w.y); s[jj][3] += bfhi(w.y); } } }
            const float* mb = mods + (size_t)(isctx ? 8 : b) * 6144; f32x4 v[4];
#pragma unroll
            for (int jj = 0; jj < 4; ++jj) { const int col = 4 * lane + 256 * jj; v[jj] = h4_f32(hv[q][jj]) + *(const f32x4*)(mb + 5 * 1024 + col) * s[jj]; }
            if (l == DEPTH - 1) { f32x4* op = (f32x4*)(out + ((size_t)b * SEQ + (j - CTX)) * DM);
#pragma unroll
                for (int jj = 0; jj < 4; ++jj) st16f(op + lane + 64 * jj, v[jj]);
            } else { u32x2* hp = (u32x2*)(H + (size_t)r * DM);
#pragma unroll
                for (int jj = 0; jj < 4; ++jj) st8(hp + lane + 64 * jj, f32_h4(v[jj]));
                const float rstd = row_rstd(v); const float* mn = modsn + (size_t)(isctx ? 8 : b) * 6144;
                norm_mod_store(v, rstd, gn, mn + 1024, mn, A + (size_t)r * DM, lane); }
        }
    }
}
__device__ __forceinline__ void ph_pool_in(Frame& F, bool with_ctx) {
    const bf16_t* A = WSP(bf16_t, WS_ABUF); bf16_t* PB = WSP(bf16_t, WS_P); bf16_t* tile = (bf16_t*)F.lds;
    const int nlat = NB * 64 * 4, ntot = nlat + (with_ctx ? NB * 4 * 4 : 0);
    auto decode = [&](int item, int& b, int& tb, int& gi, int& L, int& base) {
        if (item < nlat) { b = item >> 8; tb = (item >> 2) & 63; gi = item & 3; L = SEQ; base = b * RPB + CTX; }
        else { const int v = item - nlat; b = v >> 4; tb = (v >> 2) & 3; gi = v & 3; L = CTX; base = b * RPB; } };
    auto fetch = [&](int item, u32x4 (&pre)[5]) { int b, tb, gi, L, base; decode(item, b, tb, gi, L, base); const int hw = 1 << gi, t0 = tb * 64, nrows = 64 + 2 * hw;
#pragma unroll
        for (int k = 0; k < 5; ++k) { const int i = F.tid + k * NTHR, rr = i >> 5, ch = i & 31, t = t0 - hw + rr; u32x4 v = {0u, 0u, 0u, 0u};
            if (i < nrows * 32 && t >= 0 && t < L) v = *(const u32x4*)(A + (size_t)(base + t) * DM + gi * 256 + ch * 8);
            pre[k] = v; } };
    u32x4 cur[5], nxt[5];
    if (F.bid < ntot) fetch(F.bid, cur);
    for (int item = F.bid; item < ntot; item += F.G) {
        int b, tb, gi, L, base; decode(item, b, tb, gi, L, base);
        const int hw = 1 << gi, t0 = tb * 64, nrows = 64 + 2 * hw;
        if (item + F.G < ntot) fetch(item + F.G, nxt);
        __syncthreads();
#pragma unroll
        for (int k = 0; k < 5; ++k) { const int i = F.tid + k * NTHR, rr = i >> 5, ch = i & 31; if (i < nrows * 32) *(u32x4*)(tile + rr * 264 + ch * 8) = cur[k]; }
        __syncthreads();
        const int tr = F.tid >> 3, t = t0 + tr, lo = max(t - hw, 0), hi = min(t + hw, L); const float inv = 1.f / (float)(hi - lo);
#pragma unroll
        for (int k = 0; k < 4; ++k) { const int ch = (F.tid & 7) + 8 * k; float s[8];
#pragma unroll
            for (int q = 0; q < 8; ++q) s[q] = 0.f;
            for (int rr = tr; rr < tr + 2 * hw; ++rr) { const u32x4 w = *(const u32x4*)(tile + rr * 264 + ch * 8);
                s[0] += bflo(w.x); s[1] += bfhi(w.x); s[2] += bflo(w.y); s[3] += bfhi(w.y); s[4] += bflo(w.z); s[5] += bfhi(w.z); s[6] += bflo(w.w); s[7] += bfhi(w.w); }
            const u32x4 me = *(const u32x4*)(tile + (tr + hw) * 264 + ch * 8);
            u32x4 o; o.x = cvt_pk_bf16(s[0] * inv - bflo(me.x), s[1] * inv - bfhi(me.x)); o.y = cvt_pk_bf16(s[2] * inv - bflo(me.y), s[3] * inv - bfhi(me.y));
            o.z = cvt_pk_bf16(s[4] * inv - bflo(me.z), s[5] * inv - bfhi(me.z)); o.w = cvt_pk_bf16(s[6] * inv - bflo(me.w), s[7] * inv - bfhi(me.w));
            st16(PB + (size_t)(base + t) * DM + gi * 256 + ch * 8, o); }
#pragma unroll
        for (int k = 0; k < 5; ++k) cur[k] = nxt[k];
    }
}

template <int HW> __device__ __forceinline__ void pool_row(const bf16_t* tile, bf16_t* pbt, int tr, int tid, float inv) {
#pragma unroll
    for (int k = 0; k < 4; ++k) { const int ch = (tid & 7) + 8 * k; u32x4 w[2 * HW];
#pragma unroll
        for (int rr = 0; rr < 2 * HW; ++rr) w[rr] = *(const u32x4*)(tile + (tr + rr) * 264 + ch * 8);
        float s[8];
#pragma unroll
        for (int q = 0; q < 8; ++q) s[q] = 0.f;
#pragma unroll
        for (int rr = 0; rr < 2 * HW; ++rr) { s[0] += bflo(w[rr].x); s[1] += bfhi(w[rr].x); s[2] += bflo(w[rr].y); s[3] += bfhi(w[rr].y); s[4] += bflo(w[rr].z); s[5] += bfhi(w[rr].z); s[6] += bflo(w[rr].w); s[7] += bfhi(w[rr].w); }
        const u32x4 me = w[HW];
        u32x4 o; o.x = cvt_pk_bf16(s[0] * inv - bflo(me.x), s[1] * inv - bfhi(me.x)); o.y = cvt_pk_bf16(s[2] * inv - bflo(me.y), s[3] * inv - bfhi(me.y));
        o.z = cvt_pk_bf16(s[4] * inv - bflo(me.z), s[5] * inv - bfhi(me.z)); o.w = cvt_pk_bf16(s[6] * inv - bflo(me.w), s[7] * inv - bfhi(me.w));
        *(u32x4*)(pbt + tr * 264 + ch * 8) = o; }
}
template <int HW> __device__ __forceinline__ void pool_strip(const bf16_t* tile, bf16_t* pbt, int tid, int t0, int L) {
    const int ch = tid & 31, r0 = (tid >> 5) * 4; u32x4 w[2 * HW];
    float s[8];
#pragma unroll
    for (int q = 0; q < 8; ++q) s[q] = 0.f;
#define POOL_ACC(W, SG) do { s[0] += SG bflo((W).x); s[1] += SG bfhi((W).x); s[2] += SG bflo((W).y); s[3] += SG bfhi((W).y); s[4] += SG bflo((W).z); s[5] += SG bfhi((W).z); s[6] += SG bflo((W).w); s[7] += SG bfhi((W).w); } while (0)
#pragma unroll
    for (int b0 = 0; b0 < 2 * HW; b0 += 4) {
#pragma unroll
        for (int rr = b0; rr < b0 + 4 && rr < 2 * HW; ++rr) w[rr] = *(const u32x4*)(tile + (r0 + rr) * 264 + ch * 8);
#pragma unroll
        for (int rr = b0; rr < b0 + 4 && rr < 2 * HW; ++rr) POOL_ACC(w[rr], +);
        __builtin_amdgcn_sched_barrier(0); }
#pragma unroll
    for (int i = 0; i < 4; ++i) {
        if (i > 0) { const u32x4 wn = *(const u32x4*)(tile + (r0 + i - 1 + 2 * HW) * 264 + ch * 8); const u32x4 wo = (i - 1 < 2 * HW) ? w[(i - 1 < 2 * HW) ? i - 1 : 0] : *(const u32x4*)(tile + (r0 + i - 1) * 264 + ch * 8); POOL_ACC(wo, -); POOL_ACC(wn, +); }
        const int t = t0 + r0 + i, lo = max(t - HW, 0), hi = min(t + HW, L); const float inv = 1.f / (float)(hi - lo);
        const u32x4 me = (i + HW < 2 * HW) ? w[(i + HW < 2 * HW) ? i + HW : 0] : *(const u32x4*)(tile + (r0 + i + HW) * 264 + ch * 8);
        u32x4 o; o.x = cvt_pk_bf16(s[0] * inv - bflo(me.x), s[1] * inv - bfhi(me.x)); o.y = cvt_pk_bf16(s[2] * inv - bflo(me.y), s[3] * inv - bfhi(me.y));
        o.z = cvt_pk_bf16(s[4] * inv - bflo(me.z), s[5] * inv - bfhi(me.z)); o.w = cvt_pk_bf16(s[6] * inv - bflo(me.w), s[7] * inv - bfhi(me.w));
        *(u32x4*)(pbt + (r0 + i) * 264 + ch * 8) = o; }
#undef POOL_ACC
}
__device__ __forceinline__ void ph_pool_gemm(Frame& F, int e, int l, bool with_ctx) {
    const bf16_t* A = WSP(bf16_t, WS_ABUF); h16_t* H = WSP(h16_t, WS_H); const bf16_t* WT = WSP(bf16_t, WS_POOLT) + (size_t)e * 1024 * 256;
    const float* gate_l = WSP(float, WS_MODS) + (size_t)l * 9 * 6144 + 2 * 1024; const float* scale = F.in[I_POOLS] + e * DM;
    bf16_t* tile = (bf16_t*)F.lds;
    bf16_t* pbt = tile + 80 * 264;
    float* ct = (float*)(F.lds + (80 + 64) * 264 * 2);
    const int nlat = NB * 64 * 4, ntot = nlat + (with_ctx ? NB * 4 * 4 : 0);
    auto decode = [&](int item, int& b, int& tb, int& gi, int& L, int& base) {
        if (item < nlat) { b = item >> 8; tb = (item >> 2) & 63; gi = (item + b) & 3; L = SEQ; base = b * RPB + CTX; }
        else { const int v = item - nlat; b = v >> 4; tb = (v >> 2) & 3; gi = v & 3; L = CTX; base = b * RPB; } };
    auto fetch = [&](int item, u32x4 (&pre)[5]) { int b, tb, gi, L, base; decode(item, b, tb, gi, L, base); const int hw = 1 << gi, t0 = tb * 64, nrows = 64 + 2 * hw;
#pragma unroll
        for (int k = 0; k < 5; ++k) { const int i = F.tid + k * NTHR, rr = i >> 5, ch = i & 31, t = t0 - hw + rr; u32x4 v = {0u, 0u, 0u, 0u};
            if (i < nrows * 32 && t >= 0 && t < L) v = *(const u32x4*)(A + (size_t)(base + t) * DM + gi * 256 + ch * 8);
            pre[k] = v; } };
    const int lane = F.lane, wv = F.wave, fr = lane & 15, fg = lane >> 4;
#define LBAR() asm volatile("s_waitcnt lgkmcnt(0)\n\ts_barrier" ::: "memory")
    u32x4 cur[5], nxt[5];
    if (F.bid < ntot) fetch(F.bid, cur);
    for (int item = F.bid; item < ntot; item += F.G) {
        int b, tb, gi, L, base; decode(item, b, tb, gi, L, base);
        const int hw = 1 << gi, t0 = tb * 64, nrows = 64 + 2 * hw;
        if (item + F.G < ntot) fetch(item + F.G, nxt);
        bf16x8 bw[8][2];
#pragma unroll
        for (int ks = 0; ks < 4; ++ks)
#pragma unroll
            for (int nb = 0; nb < 2; ++nb) bw[ks][nb] = *(const bf16x8*)(WT + (size_t)(gi * 256 + 32 * wv + 16 * nb + fr) * 256 + 32 * ks + 8 * fg);
        const int erow = F.tid >> 5, ech = F.tid & 31; h16_t* hp = H + (size_t)(base + t0 + erow) * DM + gi * 256 + ech * 8;
        u32x4 hraw[4];
#pragma unroll
        for (int m = 0; m < 4; ++m) hraw[m] = *(const u32x4*)(hp + (size_t)(16 * m) * DM);
        LBAR();
#pragma unroll
        for (int k = 0; k < 5; ++k) { const int i = F.tid + k * NTHR, rr = i >> 5, ch = i & 31; if (i < nrows * 32) *(u32x4*)(tile + rr * 264 + ch * 8) = cur[k]; }
        LBAR();
        if (gi == 0) { const int tr = F.tid >> 3, t = t0 + tr, lo = max(t - hw, 0), hi = min(t + hw, L); pool_row<1>(tile, pbt, tr, F.tid, 1.f / (float)(hi - lo)); }
        else if (gi == 1) pool_strip<2>(tile, pbt, F.tid, t0, L); else if (gi == 2) pool_strip<4>(tile, pbt, F.tid, t0, L); else pool_strip<8>(tile, pbt, F.tid, t0, L);
        const float* gp = gate_l + (size_t)(L == CTX ? 8 : b) * 6144 + gi * 256 + ech * 8; const float* sp = scale + gi * 256 + ech * 8;
        const f32x4 gs0 = *(const f32x4*)gp * *(const f32x4*)sp, gs1 = *(const f32x4*)(gp + 4) * *(const f32x4*)(sp + 4);
        asm volatile("" ::: "memory");
#pragma unroll
        for (int ks = 4; ks < 8; ++ks)
#pragma unroll
            for (int nb = 0; nb < 2; ++nb) bw[ks][nb] = *(const bf16x8*)(WT + (size_t)(gi * 256 + 32 * wv + 16 * nb + fr) * 256 + 32 * ks + 8 * fg);
        LBAR();
        f32x4 acc[4][2];
#pragma unroll
        for (int m = 0; m < 4; ++m)
#pragma unroll
            for (int nb = 0; nb < 2; ++nb) acc[m][nb] = (f32x4){0.f, 0.f, 0.f, 0.f};
#pragma unroll
        for (int ks = 0; ks < 8; ++ks) { bf16x8 af[4];
#pragma unroll
            for (int m = 0; m < 4; ++m) af[m] = *(const bf16x8*)(pbt + (16 * m + fr) * 264 + 32 * ks + 8 * fg);
#pragma unroll
            for (int m = 0; m < 4; ++m)
#pragma unroll
                for (int nb = 0; nb < 2; ++nb) acc[m][nb] = __builtin_amdgcn_mfma_f32_16x16x32_bf16(af[m], bw[ks][nb], acc[m][nb], 0, 0, 0); }
#pragma unroll
        for (int m = 0; m < 4; ++m)
#pragma unroll
            for (int nb = 0; nb < 2; ++nb)
#pragma unroll
                for (int i = 0; i < 4; ++i) ct[(16 * m + 4 * fg + i) * 260 + 32 * wv + 16 * nb + fr] = acc[m][nb][i];
        LBAR();
#pragma unroll
        for (int m = 0; m < 4; ++m) { const float* cp = ct + (erow + 16 * m) * 260 + ech * 8; const f32x4 c0 = *(const f32x4*)cp, c1 = *(const f32x4*)(cp + 4);
            const f32x4 h0 = h4_f32((u32x2){hraw[m].x, hraw[m].y}), h1 = h4_f32((u32x2){hraw[m].z, hraw[m].w});
            const u32x2 o0 = f32_h4(h0 + gs0 * c0), o1 = f32_h4(h1 + gs1 * c1);
            *(u32x4*)(hp + (size_t)(16 * m) * DM) = (u32x4){o0.x, o0.y, o1.x, o1.y}; }
#pragma unroll
        for (int k = 0; k < 5; ++k) cur[k] = nxt[k];
    }
#undef LBAR
}

#ifndef ENMASK
#define ENMASK 0xFFFFFFFFu
#endif
#ifndef RPTMASK
#define RPTMASK 0u
#endif
#define EN(k, ...) do { if constexpr ((ENMASK >> (k)) & 1u) { if constexpr ((RPTMASK >> (k)) & 1u) { _Pragma("unroll 1") for (int rep_ = 0; rep_ < 2; ++rep_) { __VA_ARGS__ __syncthreads(); } } else { __VA_ARGS__ } } } while (0);
constexpr int NPHASES = 2 + 2 * 9 + 2 * 6;
__device__ __forceinline__ int opaque_tid() { int t = threadIdx.x; asm volatile("" : "+v"(t)); return t; }
__device__ __forceinline__ void mkframe(Frame& F, char* lds) {
    F.lds = lds; F.tid = opaque_tid(); F.lane = F.tid & 63; F.wave = __builtin_amdgcn_readfirstlane(F.tid >> 6);
    F.G = gridDim.x; F.bid = blockIdx.x; F.gw = F.bid * NWAVES + F.wave; F.NGW = F.G * NWAVES;
    int z = 0; asm volatile("" : "+s"(z));
    F.in = (katab_t)((__attribute__((address_space(4))) const unsigned char*)__builtin_amdgcn_kernarg_segment_ptr() + z); F.ws = (unsigned char*)F.in[32];
}
__global__ void __launch_bounds__(NTHR, 2) mk_fwd(Params prm) {
    extern __shared__ __attribute__((aligned(16))) unsigned char lds_raw[];
    volatile LAS unsigned* MISC = (volatile LAS unsigned*)((LAS unsigned char*)lds_raw + MISC_OFF);
    if (threadIdx.x < 64) MISC[threadIdx.x] = 0u;
    __syncthreads();
    const int lo = prm.ph_lo, hi = prm.ph_hi;
    XcdBarrier bar; bar.bar = (unsigned*)(prm.ws + WS_CTL); bar.x = 0; bar.st = nullptr;
    if (hi - lo > 1) bar = xcd_barrier_post((unsigned*)(prm.ws + WS_CTL), MISC + 8);
    int ph = 0;
    LAS unsigned char* ldsg = (LAS unsigned char*)lds_raw;
#define PH_BEGIN if (ph >= lo && ph < hi) { Frame F; mkframe(F, (char*)lds_raw);
#define PH_END   if (ph + 1 < hi) xcd_barrier(bar); } ++ph;

    PH_BEGIN EN(0, ph_mods(F); __syncthreads(); ph_cvt_small(F); __syncthreads();) EN(1, ph_filter_mlp(F);) PH_END
    PH_BEGIN EN(2, ph_build_gr(F); ph_init_norm_a(F);) PH_END
    for (int l = 0; l < DEPTH; ++l) {
        const int e = l >> 1; const bool ctx_full = l < 2;
        if ((l & 1) == 0) {
            PH_BEGIN {
                { float* cst = (float*)(F.lds + 131072);
                  for (int i = F.tid; i < 64 * 16; i += NTHR) { const int pos = i >> 4, k = i & 15; const float inv = exp2f(-(float)k * (13.287712379549449f / 16.f)); const float rev = (float)pos * inv * 0.15915494309189535f;
                      cst[i] = cos_rev(rev); cst[1024 + i] = sin_rev(rev); }
                  __syncthreads(); }
                pg8::Gemm g{WSP(bf16_t, WS_ABUF), WSP(bf16_t, WS_WINT) + (size_t)e * INW * DM, DM, DM, DM};
                pg8::SchedWin S; S.init(MT / 256, F.G, F.bid, (long)((WS_WINT + (size_t)e * INW * DM * 2)) - (long)WS_ABUF);
                pg8::EpiWin E{WSP(bf16_t, WS_P), WSP(bf16_t, WS_HYT), WSP(bf16_t, WS_HYC), WSP(bf16_t, WS_QB), WSP(bf16_t, WS_KB), F.in[I_QG] + e * 64, F.in[I_KG] + e * 64, (const PG8_LAS float*)(ldsg + 131072)};
                EN(3, (pg8::gemm_phase<pg8::EpiWin, pg8::SchedWin, true, true>(ldsg, g, S, E));) } PH_END
            PH_BEGIN {
                const int grp = (F.bid >> 3) & 3;
                if (grp == 0) { EN(12, ph_cvt_experts(F, l); ph_cvt_experts(F, l + 1); __syncthreads();) }
                EN(5, ph_hyena(F, e);) EN(6, if (l == 0) { __syncthreads(); ph_hyena_ctx(F, e); }) __syncthreads();
                if (grp == 1) { EN(12, ph_cvt_experts(F, l); ph_cvt_experts(F, l + 1); __syncthreads();) }
                EN(7, ph_attn(F, e, l, l == 0, 0, 2);)
                if (grp == 2) { EN(12, __syncthreads(); ph_cvt_experts(F, l); ph_cvt_experts(F, l + 1); __syncthreads();) }
                EN(7, ph_attn(F, e, l, l == 0, 2, 64);)
                if (grp == 3) { EN(12, __syncthreads(); ph_cvt_experts(F, l); ph_cvt_experts(F, l + 1);) } } PH_END
            PH_BEGIN EN(8, ph_mix(F, e, l, l == 0);) PH_END
            PH_BEGIN {
                pg8::Gemm g{WSP(bf16_t, WS_ABUF), WSP(bf16_t, WS_WOUTT) + (size_t)e * DM * DM, DM, DM, DM};
                pg8::SchedDense S; S.init(ctx_full ? MT / 256 : NB * 16, DM / 256, F.G, F.bid, ctx_full ? 0 : 1, DM, DM, 0);
                pg8::EpiResid E{WSP(h16_t, WS_H), WSP(float, WS_MODS) + (size_t)l * 9 * 6144, nullptr, 1.f, l == 0 ? F.in[I_X] : nullptr, F.in[I_CTX]};
                EN(9, (pg8::gemm_phase<pg8::EpiResid, pg8::SchedDense, true, true>(ldsg, g, S, E));)
#if ((RPTMASK >> 20) & 1u)
                { pg8::EpiResid E2{WSP(h16_t, WS_H), WSP(float, WS_MODS) + (size_t)l * 9 * 6144, nullptr, 0.f, nullptr, nullptr}; __syncthreads(); pg8::gemm_phase<pg8::EpiResid, pg8::SchedDense, true, true>(ldsg, g, S, E2); }
#endif
            } PH_END
        } else {
            PH_BEGIN EN(10, ph_pool_gemm(F, e, l, ctx_full);) PH_END
        }
        PH_BEGIN EN(13, ph_router(F, l, ctx_full);) PH_END
        PH_BEGIN EN(14, ph_topk(F, ctx_full);) PH_END
        PH_BEGIN {
            pg8::Gemm g{WSP(bf16_t, WS_XS), (bf16_t*)(F.ws + WS_W13T + (size_t)(l & 1) * W13T_BYTES), DM, DM, DM};
            pg8::SchedMoe S; S.init(ctx_full ? 17 : 16, 16, F.G, F.bid, DM, DM);
            PG8_LAS unsigned short* gtab = (PG8_LAS unsigned short*)(ldsg + 131072);
            { pg8::Unit u; const int* TOK = WSP(int, WS_TOKROW);
              for (int ui = F.tid >> 8; S.next(ui, u); ui += 2) gtab[ui * 256 + (F.tid & 255)] = (unsigned short)TOK[(size_t)u.pm * 256 + (F.tid & 255)];
              __syncthreads(); }
            pg8::EpiSwiglu E{WSP(bf16_t, WS_ACT)};
            EN(16, (pg8::gemm_phase<pg8::EpiSwiglu, pg8::SchedMoe, true, true, true>(ldsg, g, S, E, gtab));)
#if ((RPTMASK >> 23) & 1u)
            { pg8::EpiNull E2{0}; __syncthreads(); pg8::gemm_phase<pg8::EpiNull, pg8::SchedMoe, true, true, true>(ldsg, g, S, E2, gtab); }
#endif
            } PH_END
        PH_BEGIN {
            const bool split = ctx_full && moe_split(F.G);
#pragma unroll 1
            for (int pass = 0; pass < (split ? 2 : 1); ++pass) {
                pg8::Gemm g{WSP(bf16_t, WS_ACT), (bf16_t*)(F.ws + WS_W2T + (size_t)(l & 1) * W2T_BYTES), pass ? FF / 2 : FF, FF, FF};
                pg8::SchedMoe S; S.init((ctx_full && !split) ? 17 : 16, 4, F.G, F.bid, FF, FF); S.cx = pass;
                pg8::EpiDown E{WSP(bf16_t, WS_YP), WSP(float, WS_PGATE), WSP(bf16_t, WS_OBUF)};
                if (pass) __syncthreads();
                EN(17, (pg8::gemm_phase<pg8::EpiDown, pg8::SchedMoe, true, true>(ldsg, g, S, E));) } } PH_END
        PH_BEGIN EN(18, ph_combine(F, l, ctx_full);)
#if ((RPTMASK >> 22) & 1u)
            if (l < DEPTH - 1) { __syncthreads(); ph_combine(F, l, ctx_full, true); }
#endif
        PH_END
    }
#if ((RPTMASK >> 19) & 1u)
    if (hi - lo > 1) { for (int i = 0; i < 40; ++i) xcd_barrier(bar); }
#endif
#undef PH_BEGIN
#undef PH_END
}

extern "C" void kernel_launch(void* const* d_in, const int* in_sizes, int n_in, void* d_out, int out_size, void* d_ws, size_t ws_size, hipStream_t stream) {
    static int grid = 0;
    if (grid == 0) {
        if (n_in != 31 || out_size != NB * SEQ * DM || ws_size < WS_END) { fprintf(stderr, "kernel_launch: unexpected shapes (n_in %d out %d ws %zu need %zu)\n", n_in, out_size, ws_size, (size_t)WS_END); grid = -1; return; }
        int dev = 0, cus = 0, per_cu = 0;
        if (hipGetDevice(&dev) != hipSuccess || hipDeviceGetAttribute(&cus, hipDeviceAttributeMultiprocessorCount, dev) != hipSuccess) { grid = -1; return; }
        if (hipFuncSetAttribute((const void*)mk_fwd, hipFuncAttributeMaxDynamicSharedMemorySize, LDS_BYTES) != hipSuccess) { fprintf(stderr, "kernel_launch: hipFuncSetAttribute failed\n"); grid = -1; return; }
        if (hipOccupancyMaxActiveBlocksPerMultiprocessor(&per_cu, (const void*)mk_fwd, NTHR, LDS_BYTES) != hipSuccess || per_cu < 1) fprintf(stderr, "kernel_launch: occupancy query reports %d\n", per_cu);
        (void)hipGetLastError();
        grid = cus;
    }
    if (grid < 0) return;
    (void)hipMemsetAsync((char*)d_ws + WS_CTL, 0, CTL_BYTES, stream);
    Params p{};
    for (int i = 0; i < 31; ++i) p.in[i] = (const float*)d_in[i];
    p.out = (float*)d_out; p.ws = (unsigned char*)d_ws;
#if MK_ONE_LAUNCH
    p.ph_lo = 0; p.ph_hi = NPHASES;
    hipLaunchKernelGGL(mk_fwd, dim3(grid), dim3(NTHR), LDS_BYTES, stream, p);
#else
    for (int k = 0; k < NPHASES; ++k) { p.ph_lo = k; p.ph_hi = k + 1; hipLaunchKernelGGL(mk_fwd, dim3(grid), dim3(NTHR), LDS_BYTES, stream, p); }
#endif
    const hipError_t le = hipPeekAtLastError();
    if (le != hipSuccess) fprintf(stderr, "kernel_launch: launch failed: %s\n", hipGetErrorName(le));
}
```
